# Optimizing an MI355X kernel written in HIP

```python
import jax, jax.numpy as jnp
from jax import lax
import numpy as np

D_MODEL = 1024
BATCH = 32
SEQ = 2048
DEPTH = 1
DEC_BATCH = 32
DEC_SEQ = 32
PAST_LEN = 4096

CHUNK = 64
HEAD_DIM = 64
N_HEADS = D_MODEL // HEAD_DIM
N_HEADS_A = N_HEADS // 2
N_HEADS_B = N_HEADS - N_HEADS_A
D_A = N_HEADS_A * HEAD_DIM
D_B = N_HEADS_B * HEAD_DIM
D_MIX = D_A + D_B
D_IN = 3 * D_A + 3 * D_B + N_HEADS_B
IN_SPLITS = (D_A, 2 * D_A, 3 * D_A, 3 * D_A + D_B, 3 * D_A + 2 * D_B, 3 * D_A + 3 * D_B)
A_LEFT_CHUNKS = 8
A_WINDOW = A_LEFT_CHUNKS * CHUNK
A_BAND = A_WINDOW + CHUNK
REL_CLIP = 128
Q_BLOCK = 128
D_FF = ((8 * D_MODEL + 3 * 256 - 1) // (3 * 256)) * 256
PLE_DIM = 256
FORGET_BIAS_INIT = 3.0
ATTN_SCALE = HEAD_DIM ** -0.5
NEG_INF = -1e30
EPS = 1e-6

kernel_name = "hybrid_chunk_band_fox_streaming_step"


def rms_norm(x, g):
    xf = x.astype(jnp.float32)
    y = xf * lax.rsqrt(jnp.mean(xf * xf, axis=-1, keepdims=True) + EPS)
    return (y * g.astype(jnp.float32)).astype(x.dtype)


def _split_heads(x, n_heads):
    return x.reshape(*x.shape[:-1], n_heads, HEAD_DIM)


def _rel_bias(table, rel):
    return table[:, jnp.clip(rel, -REL_CLIP, REL_CLIP) + REL_CLIP].astype(jnp.float32)


def _mix_projections(h, w_in, b_f, qn_a, kn_a, qn_b, kn_b):
    proj = h @ w_in
    q_a, k_a, v_a, q_b, k_b, v_b, g_f = jnp.split(proj, IN_SPLITS, axis=-1)
    q_a = rms_norm(_split_heads(q_a, N_HEADS_A), qn_a)
    k_a = rms_norm(_split_heads(k_a, N_HEADS_A), kn_a)
    v_a = _split_heads(v_a, N_HEADS_A)
    q_b = rms_norm(_split_heads(q_b, N_HEADS_B), qn_b)
    k_b = rms_norm(_split_heads(k_b, N_HEADS_B), kn_b)
    v_b = _split_heads(v_b, N_HEADS_B)
    logf = jax.nn.log_sigmoid(g_f.astype(jnp.float32) + b_f.astype(jnp.float32))
    return q_a, k_a, v_a, q_b, k_b, v_b, logf


def chunk_band_attention_prompt(q, k, v, rel_table):
    b, t, h, d = q.shape
    n_c = t // CHUNK
    pad = ((0, 0), (A_WINDOW, 0), (0, 0), (0, 0))
    k_pad = jnp.pad(k, pad).reshape(b, n_c + A_LEFT_CHUNKS, CHUNK, h, d)
    v_pad = jnp.pad(v, pad).reshape(b, n_c + A_LEFT_CHUNKS, CHUNK, h, d)
    k_band = jnp.concatenate([k_pad[:, j:j + n_c] for j in range(A_LEFT_CHUNKS + 1)], axis=2)
    v_band = jnp.concatenate([v_pad[:, j:j + n_c] for j in range(A_LEFT_CHUNKS + 1)], axis=2)
    q_c = q.reshape(b, n_c, CHUNK, h, d)
    s = jnp.einsum("bcqhd,bckhd->bchqk", q_c, k_band).astype(jnp.float32) * ATTN_SCALE
    rel = (A_WINDOW + jnp.arange(CHUNK))[:, None] - jnp.arange(A_BAND)[None, :]
    s = s + _rel_bias(rel_table, rel)[None, None]
    valid = (jnp.arange(n_c)[:, None] + jnp.arange(A_BAND)[None, :] // CHUNK) >= A_LEFT_CHUNKS
    s = jnp.where(valid[None, :, None, None, :], s, NEG_INF)
    p = jax.nn.softmax(s, axis=-1).astype(v.dtype)
    o = jnp.einsum("bchqk,bckhd->bcqhd", p, v_band)
    return o.reshape(b, t, h, d)


def chunk_band_attention_sample(q, k, v, cache_k, cache_v, rel_table):
    w = cache_k.shape[1]
    t = q.shape[1]
    k_all = jnp.concatenate([cache_k.astype(k.dtype), k], axis=1)
    v_all = jnp.concatenate([cache_v.astype(v.dtype), v], axis=1)
    s = jnp.einsum("bqhd,bkhd->bhqk", q, k_all).astype(jnp.float32) * ATTN_SCALE
    rel = (w + jnp.arange(t))[:, None] - jnp.arange(w + t)[None, :]
    s = s + _rel_bias(rel_table, rel)[None]
    p = jax.nn.softmax(s, axis=-1).astype(v.dtype)
    return jnp.einsum("bhqk,bkhd->bqhd", p, v_all)


def forgetting_attention_prompt(q, k, v, logf):
    b, t, h, d = q.shape
    c_t = jnp.cumsum(logf, axis=1).transpose(0, 2, 1)
    k_pos = jnp.arange(t)

    def block(i):
        start = i * Q_BLOCK
        q_blk = lax.dynamic_slice_in_dim(q, start, Q_BLOCK, axis=1)
        c_q = lax.dynamic_slice_in_dim(c_t, start, Q_BLOCK, axis=2)
        q_pos = start + jnp.arange(Q_BLOCK)
        s = jnp.einsum("bqhd,bkhd->bhqk", q_blk, k).astype(jnp.float32) * ATTN_SCALE
        s = s + (c_q[:, :, :, None] - c_t[:, :, None, :])
        s = jnp.where((k_pos[None, :] <= q_pos[:, None])[None, None], s, NEG_INF)
        p = jax.nn.softmax(s, axis=-1).astype(v.dtype)
        return jnp.einsum("bhqk,bkhd->bqhd", p, v)

    o = lax.map(block, jnp.arange(t // Q_BLOCK))
    return o.transpose(1, 0, 2, 3, 4).reshape(b, t, h, d)


def forgetting_attention_sample(q, k, v, logf, cache_k, cache_v, cache_logf):
    past = cache_k.shape[1]
    t = q.shape[1]
    k_all = jnp.concatenate([cache_k.astype(k.dtype), k], axis=1)
    v_all = jnp.concatenate([cache_v.astype(v.dtype), v], axis=1)
    lf_all = jnp.concatenate([cache_logf.astype(jnp.float32), logf], axis=1)
    c_t = jnp.cumsum(lf_all, axis=1).transpose(0, 2, 1)
    c_q = c_t[:, :, past:]
    s = jnp.einsum("bqhd,bkhd->bhqk", q, k_all).astype(jnp.float32) * ATTN_SCALE
    s = s + (c_q[:, :, :, None] - c_t[:, :, None, :])
    causal = jnp.arange(past + t)[None, :] <= (past + jnp.arange(t))[:, None]
    s = jnp.where(causal[None, None], s, NEG_INF)
    p = jax.nn.softmax(s, axis=-1).astype(v.dtype)
    return jnp.einsum("bhqk,bkhd->bqhd", p, v_all)


def _layer_tail(x, o_a, o_b, p, w_out, norm_ffn, w_gate, w_up, w_down, norm_ple, w_ple_gate, w_ple_proj):
    b, t = x.shape[:2]
    o = jnp.concatenate([o_a.reshape(b, t, D_A), o_b.reshape(b, t, D_B)], axis=-1) @ w_out
    x = x + o
    h = rms_norm(x, norm_ffn)
    x = x + (jax.nn.silu(h @ w_gate) * (h @ w_up)) @ w_down
    gate = jax.nn.sigmoid(rms_norm(x, norm_ple) @ w_ple_gate)
    return x + (p @ w_ple_proj) * gate


def setup_inputs(seed: int = 0) -> dict:
    key = jax.random.key(seed)
    ks = jax.random.split(key, 32)
    f32 = jnp.float32

    def nrm(k, shape, scale):
        return scale * jax.random.normal(k, shape, f32)

    w_a = min(A_WINDOW, PAST_LEN)
    return {
        "x_prompt": nrm(ks[0], (BATCH, SEQ, D_MODEL), 1.0),
        "x_sample": nrm(ks[1], (DEC_BATCH, DEC_SEQ, D_MODEL), 1.0),
        "cache_k_a": nrm(ks[2], (DEPTH, DEC_BATCH, w_a, N_HEADS_A, HEAD_DIM), 1.0),
        "cache_v_a": nrm(ks[3], (DEPTH, DEC_BATCH, w_a, N_HEADS_A, HEAD_DIM), 1.0),
        "cache_k_b": nrm(ks[4], (DEPTH, DEC_BATCH, PAST_LEN, N_HEADS_B, HEAD_DIM), 1.0),
        "cache_v_b": nrm(ks[5], (DEPTH, DEC_BATCH, PAST_LEN, N_HEADS_B, HEAD_DIM), 1.0),
        "cache_logf_b": jax.nn.log_sigmoid(FORGET_BIAS_INIT + nrm(ks[6], (DEPTH, DEC_BATCH, PAST_LEN, N_HEADS_B), 1.0)),
        "p_prompt": nrm(ks[7], (DEPTH, BATCH, SEQ, PLE_DIM), 1.0),
        "p_sample": nrm(ks[8], (DEPTH, DEC_BATCH, DEC_SEQ, PLE_DIM), 1.0),
        "norm_mix": 1.0 + nrm(ks[9], (DEPTH, D_MODEL), 0.05),
        "w_in": nrm(ks[10], (DEPTH, D_MODEL, D_IN), D_MODEL ** -0.5),
        "b_f": FORGET_BIAS_INIT + nrm(ks[11], (DEPTH, N_HEADS_B), 0.5),
        "q_norm_a": 1.0 + nrm(ks[12], (DEPTH, HEAD_DIM), 0.05),
        "k_norm_a": 1.0 + nrm(ks[13], (DEPTH, HEAD_DIM), 0.05),
        "q_norm_b": 1.0 + nrm(ks[14], (DEPTH, HEAD_DIM), 0.05),
        "k_norm_b": 1.0 + nrm(ks[15], (DEPTH, HEAD_DIM), 0.05),
        "rel_bias_a": nrm(ks[16], (DEPTH, N_HEADS_A, 2 * REL_CLIP + 1), 0.3),
        "w_out": nrm(ks[17], (DEPTH, D_MIX, D_MODEL), D_MIX ** -0.5),
        "norm_ffn": 1.0 + nrm(ks[18], (DEPTH, D_MODEL), 0.05),
        "w_gate": nrm(ks[19], (DEPTH, D_MODEL, D_FF), D_MODEL ** -0.5),
        "w_up": nrm(ks[20], (DEPTH, D_MODEL, D_FF), D_MODEL ** -0.5),
        "w_down": nrm(ks[21], (DEPTH, D_FF, D_MODEL), D_FF ** -0.5),
        "norm_ple": 1.0 + nrm(ks[22], (DEPTH, D_MODEL), 0.05),
        "w_ple_gate": nrm(ks[23], (DEPTH, D_MODEL, D_MODEL), D_MODEL ** -0.5),
        "w_ple_proj": nrm(ks[24], (DEPTH, PLE_DIM, D_MODEL), PLE_DIM ** -0.5),
    }


def reference(x_prompt, x_sample, cache_k_a, cache_v_a, cache_k_b, cache_v_b, cache_logf_b,
              p_prompt, p_sample, norm_mix, w_in, b_f, q_norm_a, k_norm_a, q_norm_b, k_norm_b,
              rel_bias_a, w_out, norm_ffn, w_gate, w_up, w_down, norm_ple, w_ple_gate, w_ple_proj):
    xp = x_prompt
    xs = x_sample
    ka_p, va_p, kb_p, vb_p, lf_p = [], [], [], [], []
    ka_s, va_s, kb_s, vb_s, lf_s = [], [], [], [], []
    for i in range(DEPTH):
        tail_w = (w_out[i], norm_ffn[i], w_gate[i], w_up[i], w_down[i], norm_ple[i], w_ple_gate[i], w_ple_proj[i])
        h = rms_norm(xp, norm_mix[i])
        q_a, k_a, v_a, q_b, k_b, v_b, logf = _mix_projections(
            h, w_in[i], b_f[i], q_norm_a[i], k_norm_a[i], q_norm_b[i], k_norm_b[i])
        o_a = chunk_band_attention_prompt(q_a, k_a, v_a, rel_bias_a[i])
        o_b = forgetting_attention_prompt(q_b, k_b, v_b, logf)
        xp = _layer_tail(xp, o_a, o_b, p_prompt[i], *tail_w)
        t_p = k_a.shape[1]
        keep = min(A_WINDOW, t_p)
        ka_p.append(k_a[:, t_p - keep:])
        va_p.append(v_a[:, t_p - keep:])
        kb_p.append(k_b)
        vb_p.append(v_b)
        lf_p.append(logf)
        h = rms_norm(xs, norm_mix[i])
        q_a, k_a, v_a, q_b, k_b, v_b, logf = _mix_projections(
            h, w_in[i], b_f[i], q_norm_a[i], k_norm_a[i], q_norm_b[i], k_norm_b[i])
        o_a = chunk_band_attention_sample(q_a, k_a, v_a, cache_k_a[i], cache_v_a[i], rel_bias_a[i])
        o_b = forgetting_attention_sample(q_b, k_b, v_b, logf, cache_k_b[i], cache_v_b[i], cache_logf_b[i])
        xs = _layer_tail(xs, o_a, o_b, p_sample[i], *tail_w)
        ka_s.append(k_a)
        va_s.append(v_a)
        kb_s.append(k_b)
        vb_s.append(v_b)
        lf_s.append(logf)
    return (xp, xs,
            jnp.stack(ka_p), jnp.stack(va_p), jnp.stack(kb_p), jnp.stack(vb_p), jnp.stack(lf_p),
            jnp.stack(ka_s), jnp.stack(va_s), jnp.stack(kb_s), jnp.stack(vb_s), jnp.stack(lf_s))
```

```cpp
#include <hip/hip_runtime.h>
#include <hip/hip_cooperative_groups.h>
#include <cstdio>
#include <cstdint>
namespace cg = cooperative_groups;
#ifndef MK_N_LAUNCHES
#define MK_N_LAUNCHES 1
#endif
namespace pg8 {
#define PG8_LAS __attribute__((address_space(3)))
typedef unsigned short bf16_t;
typedef short bf16x8 __attribute__((ext_vector_type(8)));
typedef float f32x4 __attribute__((ext_vector_type(4)));
typedef unsigned u32x4 __attribute__((ext_vector_type(4)));
constexpr int BM = 256, BK = 64, HALF = 128, HTB = HALF * BK * 2  , STAGE_BYTES = 8 * HTB, NXCD = 8, WGM = 8;

__host__ __device__ __forceinline__ int lds_byte(int r, int c) { const int st = (r >> 4) * 2 + (c >> 5), rr = r & 15, cc = c & 31, ob = rr * 64 + cc * 2; return st * 1024 + (ob ^ (((ob >> 9) & 1) << 5)); }
__host__ __device__ __forceinline__ void stage_rc(int b, int& R, int& C) { const int st = b / 1024, sb = b % 1024, swz = sb ^ (((sb >> 9) & 1) << 5); R = (st >> 1) * 16 + swz / 64; C = (st & 1) * 32 + (swz % 64) / 2; }
__host__ __device__ __forceinline__ int perm32(int rho) { const int n = rho >> 4, i = rho & 15; return 8 * (i >> 2) + 4 * n + (i & 3); }

struct Unit { int pm, pn; };
struct Gemm { const bf16_t* A; const bf16_t* Bt; int M, N, K; };

struct StaticOrder {
    int nM, nN, nwg, G, c;
    __host__ __device__ void init(int M, int N, int G_, int c_) { nM = M / BM; nN = N / BM; nwg = nM * nN; G = G_; c = c_; }
    __host__ __device__ bool next(int i, Unit& u) const {
        const long L = (long)i * G + c; if (L >= nwg) return false;
        int wgid = (int)L; { const int q = nwg / NXCD, r = nwg % NXCD, xcd = wgid % NXCD, off = wgid / NXCD; wgid = (xcd < r ? xcd * (q + 1) : r * (q + 1) + (xcd - r) * q) + off; }
        const int nig = WGM * nN, gid = wgid / nig, fm = gid * WGM, gsz = (nM - fm) < WGM ? (nM - fm) : WGM;
        u.pm = fm + ((wgid % nig) % gsz); u.pn = (wgid % nig) / gsz; return true;
    }
    __device__ __forceinline__ void a_ready(const Unit&) const {}
    __device__ __forceinline__ void done(const Unit&) const {}
};

typedef float f32x2_cv __attribute__((ext_vector_type(2))); typedef __bf16 bf16x2_cv __attribute__((ext_vector_type(2)));
__device__ __forceinline__ unsigned cvt_pk_bf16(float lo, float hi) { const f32x2_cv v = {lo, hi}; const bf16x2_cv b = __builtin_convertvector(v, bf16x2_cv); return __builtin_bit_cast(unsigned, b); }
typedef float f32x2 __attribute__((ext_vector_type(2)));
template <class Epi, class Sched, bool ALIGN_EPI = false, bool SP2 = false>
__device__ __forceinline__ void gemm_phase(PG8_LAS unsigned char* lds, const Gemm g, const Sched& S, const Epi& E, const int wid) {
    int lane_; asm volatile("v_mbcnt_lo_u32_b32 %0, -1, 0\n\tv_mbcnt_hi_u32_b32 %0, -1, %0" : "=v"(lane_));
    const int lane = lane_, tid = wid * 64 + lane, wr = wid >> 2, wc = wid & 3, fr = lane & 15, fq = lane >> 4;
    const int K = g.K, nt = K / BK;
    unsigned voffA[2], voffB[2];
#pragma unroll
    for (int i = 0; i < 2; ++i) { int R, C; stage_rc(tid * 16 + i * 8192, R, C); const int Rb = Epi::PERM ? ((R & ~31) + perm32(R & 31)) : R;
        voffA[i] = (unsigned)(R * K + C) * 2u; voffB[i] = (unsigned)(Rb * K + C) * 2u; }
    const size_t kstep = (size_t)(BK * 2);
    const size_t hstep = (size_t)HALF * K * 2;
    const size_t tstep = 2 * hstep;
    const unsigned ldsw = (unsigned)wid * 1024u;
    const int aoff = lds_byte(wr * 64 + fr, fq * 8), boff = lds_byte(wc * 32 + fr, fq * 8);
#define PG8_SA(b, h) (((b) * 2 + (h)) * HTB)
#define PG8_SB(b, h) ((4 + (b) * 2 + (h)) * HTB)
#define PG8_STAGE(bufoff, gbase, voff) do { _Pragma("unroll") for (int _i = 0; _i < 2; ++_i) \
        __builtin_amdgcn_global_load_lds((const unsigned*)((const char*)(gbase) + (voff)[_i]), (PG8_LAS unsigned*)(lds + (bufoff) + ldsw + _i * 8192), 16, 0, 0); } while (0)
#define PG8_LDA(dst, b, h) do { _Pragma("unroll") for (int m = 0; m < 4; ++m) _Pragma("unroll") for (int k = 0; k < 2; ++k) dst[m][k] = *(const PG8_LAS bf16x8*)(lds + PG8_SA(b, h) + aoff + m * 2048 + k * 1024); } while (0)
#define PG8_LDB(dst, b, h) do { _Pragma("unroll") for (int n = 0; n < 2; ++n) _Pragma("unroll") for (int k = 0; k < 2; ++k) dst[n][k] = *(const PG8_LAS bf16x8*)(lds + PG8_SB(b, h) + boff + n * 2048 + k * 1024); } while (0)
#define PG8_MMA(ai, bj, At, Bt) do { __builtin_amdgcn_s_setprio(1); _Pragma("unroll") for (int m = 0; m < 4; ++m) _Pragma("unroll") for (int n = 0; n < 2; ++n) _Pragma("unroll") for (int k = 0; k < 2; ++k) \
        acc[ai][bj][m][n] = __builtin_amdgcn_mfma_f32_16x16x32_bf16(Bt[n][k], At[m][k], acc[ai][bj][m][n], 0, 0, 0); __builtin_amdgcn_s_setprio(0); } while (0)
#define PG8_WAIT_V(n) asm volatile("s_waitcnt vmcnt(" #n ")" ::: "memory")
#define PG8_WAIT_L(n) asm volatile("s_waitcnt lgkmcnt(" #n ")" ::: "memory")
#define PG8_BAR __builtin_amdgcn_s_barrier()
#define PG8_SCHED __builtin_amdgcn_sched_barrier(0)
    Unit cur, nxt; int ui = 0;
    if (!S.next(0, cur)) return;
    f32x4 acc[2][2][4][2];
#pragma unroll
    for (int a = 0; a < 2; ++a)
#pragma unroll
        for (int b = 0; b < 2; ++b)
#pragma unroll
            for (int m = 0; m < 4; ++m)
#pragma unroll
                for (int n = 0; n < 2; ++n) acc[a][b][m][n] = (f32x4){0.f, 0.f, 0.f, 0.f};
    bf16x8 At[4][2], B0[2][2], B1[2][2];
    const char* cA = (const char*)g.A + (size_t)cur.pm * tstep; const char* cB = (const char*)g.Bt + (size_t)cur.pn * tstep;
    S.a_ready(cur);
    if constexpr (SP2) {
        PG8_STAGE(PG8_SB(0, 0), cB, voffB); PG8_STAGE(PG8_SB(0, 1), cB + hstep, voffB); PG8_STAGE(PG8_SA(0, 0), cA, voffA); PG8_STAGE(PG8_SA(0, 1), cA + hstep, voffA);
        if (wr == 1) PG8_BAR;
        PG8_WAIT_V(2); PG8_BAR;
        PG8_STAGE(PG8_SB(1, 0), cB + kstep, voffB); PG8_STAGE(PG8_SA(1, 0), cA + kstep, voffA); PG8_STAGE(PG8_SB(1, 1), cB + hstep + kstep, voffB);
        PG8_WAIT_V(6); PG8_BAR;
    } else {
        PG8_STAGE(PG8_SB(0, 0), cB, voffB); PG8_STAGE(PG8_SA(0, 0), cA, voffA); PG8_STAGE(PG8_SB(0, 1), cB + hstep, voffB); PG8_STAGE(PG8_SA(0, 1), cA + hstep, voffA);
        if (wr == 1) PG8_BAR;
        PG8_WAIT_V(4); PG8_BAR;
        PG8_STAGE(PG8_SB(1, 0), cB + kstep, voffB); PG8_STAGE(PG8_SA(1, 0), cA + kstep, voffA); PG8_STAGE(PG8_SB(1, 1), cB + hstep + kstep, voffB);
        PG8_WAIT_V(6); PG8_BAR;
    }
    for (;;) {
        const bool has_next = S.next(ui + 1, nxt);
        const char* nA = has_next ? (const char*)g.A + (size_t)nxt.pm * tstep : cA; const char* nB = has_next ? (const char*)g.Bt + (size_t)nxt.pn * tstep : cB;
        for (int t = 0; t < nt; t += 2) {
            const bool last = (t == nt - 2);
            const char* a1 = cA + (size_t)(t + 1) * kstep;
            const char* a2 = last ? nA : cA + (size_t)(t + 2) * kstep; const char* b2 = last ? nB : cB + (size_t)(t + 2) * kstep;
            const char* a3 = a2 + kstep; const char* b3 = b2 + kstep;
            if (last && has_next) S.a_ready(nxt);
            if constexpr (SP2) {
            PG8_LDB(B0, 0, 0); PG8_LDB(B1, 0, 1); PG8_SCHED; PG8_LDA(At, 0, 0); PG8_STAGE(PG8_SA(1, 1), a1 + hstep, voffA);
            PG8_WAIT_V(8); PG8_WAIT_L(0); PG8_BAR; PG8_MMA(0, 0, At, B0); PG8_MMA(0, 1, At, B1); PG8_BAR; PG8_SCHED;
            PG8_LDA(At, 0, 1); PG8_STAGE(PG8_SB(0, 0), b2, voffB); PG8_STAGE(PG8_SB(0, 1), b2 + hstep, voffB); PG8_STAGE(PG8_SA(0, 0), a2, voffA);
            PG8_WAIT_V(8); PG8_WAIT_L(0); PG8_BAR; PG8_MMA(1, 0, At, B0); PG8_MMA(1, 1, At, B1); PG8_BAR; PG8_SCHED;
            PG8_LDB(B0, 1, 0); PG8_LDB(B1, 1, 1); PG8_SCHED; PG8_LDA(At, 1, 0); PG8_STAGE(PG8_SA(0, 1), a2 + hstep, voffA);
            PG8_WAIT_V(8); PG8_WAIT_L(0); PG8_BAR; PG8_MMA(0, 0, At, B0); PG8_MMA(0, 1, At, B1); PG8_BAR; PG8_SCHED;
            PG8_LDA(At, 1, 1); PG8_STAGE(PG8_SB(1, 0), b3, voffB); PG8_STAGE(PG8_SB(1, 1), b3 + hstep, voffB); PG8_STAGE(PG8_SA(1, 0), a3, voffA);
            PG8_WAIT_V(8); PG8_WAIT_L(0); PG8_BAR; PG8_MMA(1, 0, At, B0); PG8_MMA(1, 1, At, B1); PG8_BAR; PG8_SCHED;
            } else {
            PG8_LDB(B0, 0, 0); PG8_SCHED; PG8_LDA(At, 0, 0); PG8_STAGE(PG8_SA(1, 1), a1 + hstep, voffA);
            PG8_WAIT_L(8); PG8_BAR; PG8_WAIT_L(0); PG8_MMA(0, 0, At, B0); PG8_BAR; PG8_SCHED;
            PG8_LDB(B1, 0, 1); PG8_STAGE(PG8_SB(0, 0), b2, voffB);
            PG8_BAR; PG8_WAIT_L(0); PG8_MMA(0, 1, At, B1); PG8_BAR;
            PG8_LDA(At, 0, 1); PG8_STAGE(PG8_SA(0, 0), a2, voffA);
            PG8_BAR; PG8_WAIT_L(0); PG8_MMA(1, 0, At, B0); PG8_BAR; PG8_SCHED;
            PG8_STAGE(PG8_SB(0, 1), b2 + hstep, voffB);
            PG8_WAIT_V(6); PG8_BAR; PG8_MMA(1, 1, At, B1); PG8_BAR;
            PG8_LDB(B0, 1, 0); PG8_SCHED; PG8_LDA(At, 1, 0); PG8_STAGE(PG8_SA(0, 1), a2 + hstep, voffA);
            PG8_WAIT_L(8); PG8_BAR; PG8_WAIT_L(0); PG8_MMA(0, 0, At, B0); PG8_BAR; PG8_SCHED;
            PG8_LDB(B1, 1, 1); PG8_STAGE(PG8_SB(1, 0), b3, voffB);
            PG8_BAR; PG8_WAIT_L(0); PG8_MMA(0, 1, At, B1); PG8_BAR;
            PG8_LDA(At, 1, 1); PG8_STAGE(PG8_SA(1, 0), a3, voffA);
            PG8_BAR; PG8_WAIT_L(0); PG8_MMA(1, 0, At, B0); PG8_BAR; PG8_SCHED;
            PG8_STAGE(PG8_SB(1, 1), b3 + hstep, voffB);
            PG8_WAIT_V(6); PG8_BAR; PG8_MMA(1, 1, At, B1); PG8_BAR;
            }
        }
        if constexpr (ALIGN_EPI) { if (wr == 0) PG8_BAR; }
        if constexpr (!Epi::AFTER_DRAIN) { E(acc, cur, wr, wc, fr, fq); S.done(cur); }
        if (!has_next) break;
#pragma unroll
        for (int a = 0; a < 2; ++a)
#pragma unroll
            for (int b = 0; b < 2; ++b)
#pragma unroll
                for (int m = 0; m < 4; ++m)
#pragma unroll
                    for (int n = 0; n < 2; ++n) acc[a][b][m][n] = (f32x4){0.f, 0.f, 0.f, 0.f};
        cur = nxt; cA = nA; cB = nB; ++ui;
        if constexpr (ALIGN_EPI) { if (wr == 1) PG8_BAR; }
    }
    PG8_WAIT_V(0);
    if constexpr (!ALIGN_EPI) { if (wr == 0) PG8_BAR; }
    PG8_BAR;
    if constexpr (Epi::AFTER_DRAIN) { E.fused(acc, cur, wr, wc, fr, fq, lds, wid, lane); S.done(cur); }
#undef PG8_SA
#undef PG8_SB
#undef PG8_STAGE
#undef PG8_LDA
#undef PG8_LDB
#undef PG8_MMA
#undef PG8_WAIT_V
#undef PG8_WAIT_L
#undef PG8_BAR
#undef PG8_SCHED
}
}

#define LAS __attribute__((address_space(3)))
using pg8::bf16_t; using pg8::bf16x8; using pg8::f32x4; using pg8::u32x4; using pg8::Unit; using pg8::cvt_pk_bf16;
typedef float f32x16 __attribute__((ext_vector_type(16)));
typedef unsigned u32x2 __attribute__((ext_vector_type(2)));
typedef short v4i16_t __attribute__((ext_vector_type(4)));

constexpr int MP = 32 * 2048, MS = 32 * 32, MT = MP + MS;
constexpr int DIN = 3080, NQKV = 3072, DFF = 2816, PLE = 256;
constexpr int TA_S = 544, TB_S = 4128;
constexpr float EPS = 1e-6f, LOG2E = 1.4426950408889634f, QSCALE = 0.125f * LOG2E, NEGB = -1e30f;
constexpr size_t O_Y = 0, O_KA_P = (size_t)MT * 1024, O_VA_P = O_KA_P + 32u * 512 * 512, O_KB_P = O_VA_P + 32u * 512 * 512, O_VB_P = O_KB_P + (size_t)MP * 512,
                 O_LF_P = O_VB_P + (size_t)MP * 512, O_KA_S = O_LF_P + (size_t)MP * 8, O_VA_S = O_KA_S + (size_t)MS * 512, O_KB_S = O_VA_S + (size_t)MS * 512,
                 O_VB_S = O_KB_S + (size_t)MS * 512, O_LF_S = O_VB_S + (size_t)MS * 512, O_END = O_LF_S + (size_t)MS * 8;
constexpr size_t MiB = 1u << 20;
constexpr size_t WS_WQKV = 1 * MiB, WS_WO = 7 * MiB, WS_WGU = 9 * MiB, WS_WD = 20 * MiB, WS_WPG = 26 * MiB, WS_WPP = 28 * MiB, WS_GAINS = 28 * MiB + 768 * 1024, WS_RSTD0 = 29 * MiB, WS_SSQ1 = 30 * MiB, WS_SSQ2 = 35 * MiB;
constexpr size_t WS_XB = 40 * MiB, WS_PB = 170 * MiB, WS_O = 203 * MiB, WS_QKVP = 333 * MiB, WS_H = 333 * MiB;
constexpr size_t WS_QAS = 717 * MiB, WS_QBS = 718 * MiB, WS_KAN = 719 * MiB, WS_VAN = 720 * MiB, WS_KBN = 721 * MiB, WS_VBN = 722 * MiB, WS_PP = 723 * MiB, WS_END = 853 * MiB;
constexpr size_t PSTRIDE = (size_t)32 * 8 * 2048 * 64;
constexpr int LDS_BYTES = 147456;

struct Args { const float* in[25]; float* out; unsigned char* ws; int ph_lo, ph_hi; };

__device__ __forceinline__ int lane_id_fresh() { int l; asm volatile("v_mbcnt_lo_u32_b32 %0, -1, 0\n\tv_mbcnt_hi_u32_b32 %0, -1, %0" : "=v"(l)); return l; }
__device__ __forceinline__ float wave_sum(float v) {
#pragma unroll
    for (int o = 1; o < 64; o <<= 1) v += __shfl_xor(v, o);
    return v;
}
__device__ __forceinline__ float bf_lo(unsigned u) { return __uint_as_float(u << 16); }
__device__ __forceinline__ float bf_hi(unsigned u) { return __uint_as_float(u & 0xffff0000u); }
__device__ __forceinline__ float fast_rcp(float x) { return __builtin_amdgcn_rcpf(x); }
__device__ __forceinline__ float fast_exp2(float x) { return __builtin_amdgcn_exp2f(x); }

struct EpiQKV {
    static constexpr bool PERM = true, AFTER_DRAIN = false;
    const float* rstd0; const float* gains; unsigned char* ws; float* out;
    __device__ __forceinline__ void operator()(const f32x4 (&acc)[2][2][4][2], const Unit& u, int wr, int wc, int fr, int fq) const {
        const int kind = u.pn >> 1, head = ((u.pn & 1) << 2) + wc, sub = kind % 3; const bool isB = kind >= 3;
        f32x4 gn[2][2];
        if (sub != 2) { const float* gp = gains + ((isB ? 2 : 0) + sub) * 64; const float sc = sub == 0 ? QSCALE : 1.0f;
#pragma unroll
            for (int bj = 0; bj < 2; ++bj)
#pragma unroll
                for (int n = 0; n < 2; ++n) gn[bj][n] = *(const f32x4*)(gp + 32 * bj + 8 * fq + 4 * n) * sc; }
        else { gn[0][0] = gn[0][1] = gn[1][0] = gn[1][1] = (f32x4){1.f, 1.f, 1.f, 1.f}; }
#pragma unroll
        for (int ai = 0; ai < 2; ++ai)
#pragma unroll
            for (int m = 0; m < 4; ++m) {
                const int rl = ai * 128 + wr * 64 + m * 16 + fr, row = u.pm * 256 + rl;
                const float rs = rstd0[row];
                f32x4 v[2][2];
#pragma unroll
                for (int bj = 0; bj < 2; ++bj)
#pragma unroll
                    for (int n = 0; n < 2; ++n) v[bj][n] = acc[ai][bj][m][n] * rs;
                if (sub != 2) {
                    float ss = 0.f;
#pragma unroll
                    for (int bj = 0; bj < 2; ++bj)
#pragma unroll
                        for (int n = 0; n < 2; ++n) { const f32x4 x = v[bj][n]; ss += (x[0] * x[0] + x[1] * x[1]) + (x[2] * x[2] + x[3] * x[3]); }
                    ss += __shfl_xor(ss, 16); ss += __shfl_xor(ss, 32);
                    const float hr = rsqrtf(ss * (1.0f / 64.0f) + EPS);
#pragma unroll
                    for (int bj = 0; bj < 2; ++bj)
#pragma unroll
                        for (int n = 0; n < 2; ++n) v[bj][n] = v[bj][n] * hr * gn[bj][n];
                }
                bf16_t* dst; float* fo = nullptr;
                if (u.pm < 256) {
                    const int b = u.pm >> 3, t = ((u.pm & 7) << 8) + rl;
                    dst = (bf16_t*)(ws + WS_QKVP) + (size_t)kind * PSTRIDE + ((size_t)(b * 8 + head) * 2048 + t) * 64;
                    if (sub != 0) {
                        if (isB) fo = out + (sub == 1 ? O_KB_P : O_VB_P) + ((size_t)(b * 2048 + t) * 8 + head) * 64;
                        else if (t >= 1536) fo = out + (sub == 1 ? O_KA_P : O_VA_P) + ((size_t)(b * 512 + (t - 1536)) * 8 + head) * 64;
                    }
                } else {
                    const int rp = (u.pm - 256) * 256 + rl, b = rp >> 5, t = rp & 31;
                    if (sub == 0) dst = (bf16_t*)(ws + (isB ? WS_QBS : WS_QAS)) + ((size_t)(b * 8 + head) * 32 + t) * 64;
                    else if (!isB) { dst = (bf16_t*)(ws + (sub == 1 ? WS_KAN : WS_VAN)) + ((size_t)(b * 8 + head) * 32 + t) * 64;
                                     fo = out + (sub == 1 ? O_KA_S : O_VA_S) + ((size_t)(b * 32 + t) * 8 + head) * 64; }
                    else { dst = (bf16_t*)(ws + (sub == 1 ? WS_KBN : WS_VBN)) + ((size_t)(b * 8 + head) * 32 + t) * 64;
                           fo = out + (sub == 1 ? O_KB_S : O_VB_S) + ((size_t)(b * 32 + t) * 8 + head) * 64; }
                }
#pragma unroll
                for (int bj = 0; bj < 2; ++bj) {
                    const int col = 32 * bj + 8 * fq; const f32x4 v0 = v[bj][0], v1 = v[bj][1];
                    u32x4 w; w.x = cvt_pk_bf16(v0[0], v0[1]); w.y = cvt_pk_bf16(v0[2], v0[3]); w.z = cvt_pk_bf16(v1[0], v1[1]); w.w = cvt_pk_bf16(v1[2], v1[3]);
                    *(u32x4*)(dst + col) = w;
                    if (fo) { *(f32x4*)(fo + col) = v0; *(f32x4*)(fo + col + 4) = v1; }
                }
            }
    }
};
struct EpiStore {
    static constexpr bool PERM = true, AFTER_DRAIN = false;
    bf16_t* O; int ldc;
    __device__ __forceinline__ void operator()(const f32x4 (&acc)[2][2][4][2], const Unit& u, int wr, int wc, int fr, int fq) const {
#pragma unroll
        for (int ai = 0; ai < 2; ++ai)
#pragma unroll
            for (int m = 0; m < 4; ++m) { const int row = u.pm * 256 + ai * 128 + wr * 64 + m * 16 + fr;
#pragma unroll
                for (int bj = 0; bj < 2; ++bj) { const int col = u.pn * 256 + 128 * bj + 32 * wc + 8 * fq; const f32x4 v0 = acc[ai][bj][m][0], v1 = acc[ai][bj][m][1];
                    u32x4 w; w.x = cvt_pk_bf16(v0[0], v0[1]); w.y = cvt_pk_bf16(v0[2], v0[3]); w.z = cvt_pk_bf16(v1[0], v1[1]); w.w = cvt_pk_bf16(v1[2], v1[3]);
                    *(u32x4*)(O + (size_t)row * ldc + col) = w; } }
    }
};
template <bool F32BASE> struct EpiRes {
    static constexpr bool PERM = true, AFTER_DRAIN = false;
    const float* base_p; const float* base_s; bf16_t* xb; float* ssq;
    __device__ __forceinline__ void operator()(const f32x4 (&acc)[2][2][4][2], const Unit& u, int wr, int wc, int fr, int fq) const {
#pragma unroll
        for (int ai = 0; ai < 2; ++ai)
#pragma unroll
            for (int m = 0; m < 4; ++m) { const int row = u.pm * 256 + ai * 128 + wr * 64 + m * 16 + fr;
                const float* bp = (u.pm < 256) ? base_p + (size_t)row * 1024 : base_s + (size_t)(row - MP) * 1024;
                float s = 0.f;
#pragma unroll
                for (int bj = 0; bj < 2; ++bj) { const int col = u.pn * 256 + 128 * bj + 32 * wc + 8 * fq;
                    f32x4 r0, r1;
                    if (F32BASE) { r0 = *(const f32x4*)(bp + col); r1 = *(const f32x4*)(bp + col + 4); }
                    else { const u32x4 rw = *(const u32x4*)(xb + (size_t)row * 1024 + col); r0 = (f32x4){bf_lo(rw.x), bf_hi(rw.x), bf_lo(rw.y), bf_hi(rw.y)}; r1 = (f32x4){bf_lo(rw.z), bf_hi(rw.z), bf_lo(rw.w), bf_hi(rw.w)}; }
                    const f32x4 v0 = acc[ai][bj][m][0] + r0, v1 = acc[ai][bj][m][1] + r1;
                    u32x4 w; w.x = cvt_pk_bf16(v0[0], v0[1]); w.y = cvt_pk_bf16(v0[2], v0[3]); w.z = cvt_pk_bf16(v1[0], v1[1]); w.w = cvt_pk_bf16(v1[2], v1[3]);
                    *(u32x4*)(xb + (size_t)row * 1024 + col) = w;
                    s += (v0[0] * v0[0] + v0[1] * v0[1]) + (v0[2] * v0[2] + v0[3] * v0[3]) + (v1[0] * v1[0] + v1[1] * v1[1]) + (v1[2] * v1[2] + v1[3] * v1[3]); }
                s += __shfl_xor(s, 16); s += __shfl_xor(s, 32);
                if (fq == 0) ssq[(size_t)row * 16 + u.pn * 4 + wc] = s; }
    }
};
__device__ __forceinline__ float row_rstd(const float* ssq, int row) {
    const f32x4 a = *(const f32x4*)(ssq + (size_t)row * 16), b = *(const f32x4*)(ssq + (size_t)row * 16 + 4), c = *(const f32x4*)(ssq + (size_t)row * 16 + 8), d = *(const f32x4*)(ssq + (size_t)row * 16 + 12);
    const float t = ((a[0] + a[1]) + (a[2] + a[3])) + ((b[0] + b[1]) + (b[2] + b[3])) + ((c[0] + c[1]) + (c[2] + c[3])) + ((d[0] + d[1]) + (d[2] + d[3]));
    return rsqrtf(t * (1.0f / 1024.0f) + EPS);
}
struct EpiSwiGLU {
    static constexpr bool PERM = true, AFTER_DRAIN = false;
    const float* ssq; bf16_t* H;
    __device__ __forceinline__ void operator()(const f32x4 (&acc)[2][2][4][2], const Unit& u, int wr, int wc, int fr, int fq) const {
#pragma unroll
        for (int ai = 0; ai < 2; ++ai)
#pragma unroll
            for (int m = 0; m < 4; ++m) { const int row = u.pm * 256 + ai * 128 + wr * 64 + m * 16 + fr; const float rs = row_rstd(ssq, row);
                float hv[8];
#pragma unroll
                for (int n = 0; n < 2; ++n)
#pragma unroll
                    for (int e = 0; e < 4; ++e) { const float g = acc[ai][0][m][n][e] * rs, up = acc[ai][1][m][n][e] * rs;
                        hv[4 * n + e] = g * up * fast_rcp(1.0f + fast_exp2(-g * LOG2E)); }
                u32x4 w; w.x = cvt_pk_bf16(hv[0], hv[1]); w.y = cvt_pk_bf16(hv[2], hv[3]); w.z = cvt_pk_bf16(hv[4], hv[5]); w.w = cvt_pk_bf16(hv[6], hv[7]);
                *(u32x4*)(H + (size_t)row * DFF + u.pn * 128 + 32 * wc + 8 * fq) = w; }
    }
};
struct EpiPle {
    static constexpr bool PERM = true, AFTER_DRAIN = false;
    const float* ssq; const bf16_t* PP; const bf16_t* xb; float* y;
    __device__ __forceinline__ void operator()(const f32x4 (&acc)[2][2][4][2], const Unit& u, int wr, int wc, int fr, int fq) const {
#pragma unroll
        for (int ai = 0; ai < 2; ++ai)
#pragma unroll
            for (int m = 0; m < 4; ++m) { const int row = u.pm * 256 + ai * 128 + wr * 64 + m * 16 + fr; const float rs = row_rstd(ssq, row);
#pragma unroll
                for (int bj = 0; bj < 2; ++bj) { const int col = u.pn * 256 + 128 * bj + 32 * wc + 8 * fq; float* yp = y + (size_t)row * 1024 + col;
                    const u32x4 pw = *(const u32x4*)(PP + (size_t)row * 1024 + col);
                    const u32x4 xw = *(const u32x4*)(xb + (size_t)row * 1024 + col);
                    const f32x4 x0 = (f32x4){bf_lo(xw.x), bf_hi(xw.x), bf_lo(xw.y), bf_hi(xw.y)}, x1 = (f32x4){bf_lo(xw.z), bf_hi(xw.z), bf_lo(xw.w), bf_hi(xw.w)};
                    const f32x4 a0 = acc[ai][bj][m][0] * rs, a1 = acc[ai][bj][m][1] * rs;
                    f32x4 o0, o1;
                    o0[0] = x0[0] + bf_lo(pw.x) * fast_rcp(1.0f + fast_exp2(-a0[0] * LOG2E)); o0[1] = x0[1] + bf_hi(pw.x) * fast_rcp(1.0f + fast_exp2(-a0[1] * LOG2E));
                    o0[2] = x0[2] + bf_lo(pw.y) * fast_rcp(1.0f + fast_exp2(-a0[2] * LOG2E)); o0[3] = x0[3] + bf_hi(pw.y) * fast_rcp(1.0f + fast_exp2(-a0[3] * LOG2E));
                    o1[0] = x1[0] + bf_lo(pw.z) * fast_rcp(1.0f + fast_exp2(-a1[0] * LOG2E)); o1[1] = x1[1] + bf_hi(pw.z) * fast_rcp(1.0f + fast_exp2(-a1[1] * LOG2E));
                    o1[2] = x1[2] + bf_lo(pw.w) * fast_rcp(1.0f + fast_exp2(-a1[2] * LOG2E)); o1[3] = x1[3] + bf_hi(pw.w) * fast_rcp(1.0f + fast_exp2(-a1[3] * LOG2E));
                    *(f32x4*)yp = o0; *(f32x4*)(yp + 4) = o1; } }
    }
};

__device__ __forceinline__ void tr_item(const float* W, int ldw, int K, int srccol0, bf16_t* WT, int dstrow0, const float* gain, LAS float* scr, int kb, int lane) {
    const int k0 = 64 * kb;
#pragma unroll 8
    for (int i = 0; i < 32; ++i) { const int kk = 2 * i + (lane >> 5); float v = W[(size_t)(k0 + kk) * ldw + srccol0 + (lane & 31)]; if (gain) v *= gain[k0 + kk]; scr[kk * 33 + (lane & 31)] = v; }
    asm volatile("s_waitcnt lgkmcnt(0)" ::: "memory");
    const int c = lane & 7;
#pragma unroll
    for (int j = 0; j < 4; ++j) { const int n = (lane >> 3) + 8 * j; const LAS float* s = scr + (8 * c) * 33 + n;
        u32x4 o; o.x = cvt_pk_bf16(s[0 * 33], s[1 * 33]); o.y = cvt_pk_bf16(s[2 * 33], s[3 * 33]); o.z = cvt_pk_bf16(s[4 * 33], s[5 * 33]); o.w = cvt_pk_bf16(s[6 * 33], s[7 * 33]);
        *(u32x4*)(WT + (size_t)(dstrow0 + n) * K + k0 + 8 * c) = o; }
    asm volatile("s_waitcnt lgkmcnt(0)" ::: "memory");
}
__device__ __forceinline__ void cvt8(const float* src, bf16_t* dst) {
    const f32x4 a = *(const f32x4*)src, b = *(const f32x4*)(src + 4);
    u32x4 w; w.x = cvt_pk_bf16(a[0], a[1]); w.y = cvt_pk_bf16(a[2], a[3]); w.z = cvt_pk_bf16(b[0], b[1]); w.w = cvt_pk_bf16(b[2], b[3]);
    *(u32x4*)dst = w;
}
__device__ __forceinline__ void tr_set(const Args& a, LAS unsigned char* lds, int wave, int lane, const int set, int gw, int NGW) {
    unsigned char* ws = a.ws;
    LAS float* scr = (LAS float*)(lds + wave * 16384);
    constexpr int I_QKV = 16 * 96, I_O = 16 * 32, I_GU = 16 * 176, I_D = 44 * 32, I_PG = 16 * 32, I_PP = 4 * 32;
    const int ntot = set == 0 ? I_QKV : (set == 1 ? I_O + I_GU : I_D + I_PG + I_PP);
    for (int it = gw; it < ntot; it += NGW) {
        int r = it;
        if (set == 0) { const int kb = r / 96, nb = r % 96, pn = nb >> 3, bj = (nb >> 2) & 1, wc = nb & 3;
            tr_item(a.in[10], DIN, 1024, 256 * pn + 64 * wc + 32 * bj, (bf16_t*)(ws + WS_WQKV), 32 * nb, a.in[9], scr, kb, lane); continue; }
        if (set == 1) {
            if (r < I_O) { const int kb = r / 32, nb = r % 32; tr_item(a.in[17], 1024, 1024, 32 * nb, (bf16_t*)(ws + WS_WO), 32 * nb, nullptr, scr, kb, lane); continue; } r -= I_O;
            { const int kb = r / 176, nb = r % 176, pn = nb >> 3, bj = (nb >> 2) & 1, q = nb & 3;
              tr_item(bj ? a.in[20] : a.in[19], DFF, 1024, 128 * pn + 32 * q, (bf16_t*)(ws + WS_WGU), 32 * nb, a.in[18], scr, kb, lane); continue; }
        }
        if (r < I_D) { const int kb = r / 32, nb = r % 32; tr_item(a.in[21], 1024, DFF, 32 * nb, (bf16_t*)(ws + WS_WD), 32 * nb, nullptr, scr, kb, lane); continue; } r -= I_D;
        if (r < I_PG) { const int kb = r / 32, nb = r % 32; tr_item(a.in[23], 1024, 1024, 32 * nb, (bf16_t*)(ws + WS_WPG), 32 * nb, a.in[22], scr, kb, lane); continue; } r -= I_PG;
        { const int kb = r / 32, nb = r % 32; tr_item(a.in[24], 1024, PLE, 32 * nb, (bf16_t*)(ws + WS_WPP), 32 * nb, nullptr, scr, kb, lane); }
    }
}
__device__ __forceinline__ void shadow_share(int nu, int G, int c, int& rank, int& count) {
    const int tailc = nu - (nu / G) * G; const bool split = tailc > 0 && tailc * 2 < G;
    if (!split) { rank = c; count = G; } else if (c >= tailc) { rank = c - tailc; count = G - tailc; } else { rank = 0; count = 0; }
}
__device__ __forceinline__ void p_convert(const Args& a, const size_t gt, const size_t NT) {
    unsigned char* ws = a.ws;
    for (size_t i0 = gt; i0 < (size_t)MT * 32; i0 += 4 * NT) {
        f32x4 r[4][2];
#pragma unroll
        for (int q = 0; q < 4; ++q) { const size_t i = i0 + q * NT; if (i < (size_t)MT * 32) { const size_t row = i >> 5; const int c8 = (int)(i & 31);
            const float* src = row < (size_t)MP ? a.in[7] + row * 256 + c8 * 8 : a.in[8] + (row - MP) * 256 + c8 * 8; r[q][0] = *(const f32x4*)src; r[q][1] = *(const f32x4*)(src + 4); } }
#pragma unroll
        for (int q = 0; q < 4; ++q) { const size_t i = i0 + q * NT; if (i < (size_t)MT * 32) {
            u32x4 w; w.x = cvt_pk_bf16(r[q][0][0], r[q][0][1]); w.y = cvt_pk_bf16(r[q][0][2], r[q][0][3]); w.z = cvt_pk_bf16(r[q][1][0], r[q][1][1]); w.w = cvt_pk_bf16(r[q][1][2], r[q][1][3]);
            *(u32x4*)((bf16_t*)(ws + WS_PB) + i * 8) = w; } }
    }
}
__device__ __forceinline__ void phase0(const Args& a, LAS unsigned char* lds, int wave) {
    const int lane = lane_id_fresh(), tid = wave * 64 + lane;
    unsigned char* ws = a.ws;
    const int gw = blockIdx.x * 8 + wave, NGW = gridDim.x * 8;
    tr_set(a, lds, wave, lane, 0, gw, NGW);
    if (blockIdx.x == 0 && tid < 256) { const int w = tid >> 6, d = tid & 63; ((float*)(ws + WS_GAINS))[tid] = a.in[12 + w][d]; }
    if (blockIdx.x == 0 && wave == 0) {
        float ga = fabsf(a.in[12][lane]), ka = fabsf(a.in[13][lane]), gb = fabsf(a.in[14][lane]), kb = fabsf(a.in[15][lane]);
#pragma unroll
        for (int o = 1; o < 64; o <<= 1) { ga = fmaxf(ga, __shfl_xor(ga, o)); ka = fmaxf(ka, __shfl_xor(ka, o)); gb = fmaxf(gb, __shfl_xor(gb, o)); kb = fmaxf(kb, __shfl_xor(kb, o)); }
        if (lane == 0) { ((float*)(ws + WS_GAINS))[256] = 64.0f * QSCALE * ga * ka + 1.0f; ((float*)(ws + WS_GAINS))[257] = 64.0f * QSCALE * gb * kb + 1.0f; }
    }
    if (blockIdx.x == 0) {
        const float* tb = a.in[16] + wave * 257;
        float mx = fmaxf(fmaxf(tb[lane], tb[lane + 64]), fmaxf(tb[lane + 128], tb[lane + 192])); mx = fmaxf(mx, tb[256]);
#pragma unroll
        for (int o = 1; o < 64; o <<= 1) mx = fmaxf(mx, __shfl_xor(mx, o));
        if (lane == 0) ((float*)(ws + WS_GAINS))[264 + wave] = mx;
    }
    __syncthreads();
    {
        LAS float* wf = (LAS float*)lds;
        for (int i = tid; i < 8192; i += 512) { const int j = i >> 10, k = i & 1023; wf[i] = a.in[9][k] * a.in[10][(size_t)k * DIN + 3072 + j]; }
        __syncthreads();
        f32x4 wr[8][4];
#pragma unroll
        for (int jj = 0; jj < 8; ++jj)
#pragma unroll
            for (int j = 0; j < 4; ++j) wr[jj][j] = *(const LAS f32x4*)(wf + jj * 1024 + (lane + 64 * j) * 4);
        for (int row0 = gw; row0 < MT; row0 += 2 * NGW) {
            f32x4 vv[2][4];
#pragma unroll
            for (int rr = 0; rr < 2; ++rr) { const int row = row0 + rr * NGW < MT ? row0 + rr * NGW : row0;
                const float* xr = row < MP ? a.in[0] + (size_t)row * 1024 : a.in[1] + (size_t)(row - MP) * 1024;
#pragma unroll
                for (int j = 0; j < 4; ++j) vv[rr][j] = ((const f32x4*)xr)[lane + 64 * j]; }
#pragma unroll
            for (int rr = 0; rr < 2; ++rr) {
                const int row = row0 + rr * NGW;
                if (row >= MT) break;
                f32x4 v[4];
#pragma unroll
                for (int j = 0; j < 4; ++j) v[j] = vv[rr][j];
                float ss = 0.f;
#pragma unroll
                for (int j = 0; j < 4; ++j) ss += (v[j][0] * v[j][0] + v[j][1] * v[j][1]) + (v[j][2] * v[j][2] + v[j][3] * v[j][3]);
                u32x2* xo = (u32x2*)((bf16_t*)(ws + WS_XB) + (size_t)row * 1024);
#pragma unroll
                for (int j = 0; j < 4; ++j) { u32x2 w; w.x = cvt_pk_bf16(v[j][0], v[j][1]); w.y = cvt_pk_bf16(v[j][2], v[j][3]); xo[lane + 64 * j] = w; }
                float d[8];
#pragma unroll
                for (int jj = 0; jj < 8; ++jj) { float t = 0.f;
#pragma unroll
                    for (int j = 0; j < 4; ++j) { const f32x4 w = wr[jj][j]; t += (v[j][0] * w[0] + v[j][1] * w[1]) + (v[j][2] * w[2] + v[j][3] * w[3]); }
                    d[jj] = t; }
                const bool b5 = (lane & 32) != 0, b4 = (lane & 16) != 0, b3 = (lane & 8) != 0;
                float e4[4], e2[2];
#pragma unroll
                for (int j = 0; j < 4; ++j) { const float snd = b5 ? d[j] : d[j + 4], kp = b5 ? d[j + 4] : d[j]; e4[j] = kp + __shfl_xor(snd, 32); }
#pragma unroll
                for (int j = 0; j < 2; ++j) { const float snd = b4 ? e4[j] : e4[j + 2], kp = b4 ? e4[j + 2] : e4[j]; e2[j] = kp + __shfl_xor(snd, 16); }
                float g; { const float snd = b3 ? e2[0] : e2[1], kp = b3 ? e2[1] : e2[0]; g = kp + __shfl_xor(snd, 8); }
                g += __shfl_xor(g, 4); g += __shfl_xor(g, 2); g += __shfl_xor(g, 1);
                const float rstd = rsqrtf(wave_sum(ss) * (1.0f / 1024.0f) + EPS);
                if ((lane & 7) == 0) { const int k = lane >> 3; g = g * rstd + a.in[11][k]; const float lf = fminf(g, 0.f) - log1pf(expf(-fabsf(g)));
                    float* dst = row < MP ? a.out + O_LF_P + (size_t)row * 8 : a.out + O_LF_S + (size_t)(row - MP) * 8; dst[k] = lf; }
                if (lane == 0) ((float*)(ws + WS_RSTD0))[row] = rstd;
            }
        }
    }
}

__device__ __forceinline__ int crow(int r, int hi) { return (r & 3) + 8 * (r >> 2) + 4 * hi; }
__device__ __forceinline__ void split3(float t, unsigned& h, unsigned& m, unsigned& l) {
    h = cvt_pk_bf16(t, 0.f) & 0xffffu; const float r1 = t - __uint_as_float(h << 16);
    m = cvt_pk_bf16(r1, 0.f) & 0xffffu; const float r2 = r1 - __uint_as_float(m << 16);
    l = cvt_pk_bf16(r2, 0.f) & 0xffffu;
}
__device__ __forceinline__ float qk_bound(const unsigned char* ws, const bool modeB, int lane) {
    (void)lane; return *(volatile const float*)((const float*)(ws + WS_GAINS) + 256 + (modeB ? 1 : 0));
}
__device__ __forceinline__ bf16x8 pack8(float a0, float a1, float a2, float a3, float a4, float a5, float a6, float a7) {
    u32x4 w; w.x = cvt_pk_bf16(a0, a1); w.y = cvt_pk_bf16(a2, a3); w.z = cvt_pk_bf16(a4, a5); w.w = cvt_pk_bf16(a6, a7); return __builtin_bit_cast(bf16x8, w);
}
constexpr int A_KS = 0, A_VS = 36864, A_TAB = 73728, A_TSP = 81920, A_WSF = 98304, A_SCAN = 100352, KVT = 128 * 72;
__device__ __forceinline__ void attn_tile(const LAS bf16_t* Kt, const LAS bf16_t* Vt, const bf16x8 (&qr)[4], const LAS float* tab, LAS float* wsf, const bool modeB, const int kb0, const int qw,
                                          const int lane, f32x16& o0, f32x16& o1, float& mrun, float& lrun, const bf16x8 bq = (bf16x8){0, 0, 0, 0, 0, 0, 0, 0}, const LAS u32x2* tsp = nullptr) {
    const int r32 = lane & 31, hi = lane >> 5, qa = qw + r32;
    bf16x8 kf0[4], kf1[4];
#pragma unroll
    for (int d0 = 0; d0 < 4; ++d0) { kf0[d0] = *(const LAS bf16x8*)(Kt + r32 * 72 + d0 * 16 + hi * 8); kf1[d0] = *(const LAS bf16x8*)(Kt + (32 + r32) * 72 + d0 * 16 + hi * 8); }
    const LAS bf16_t* vb = Vt + (4 * hi + ((lane & 15) >> 2)) * 72 + 16 * ((lane >> 4) & 1) + 4 * (lane & 3);
    v4i16_t vlo[8], vup[8];
#pragma unroll
    for (int g = 0; g < 4; ++g)
#pragma unroll
        for (int d0 = 0; d0 < 2; ++d0) {
            vlo[2 * g + d0] = __builtin_amdgcn_ds_read_tr16_b64_v4i16((LAS v4i16_t*)(vb + (16 * g) * 72 + 32 * d0));
            vup[2 * g + d0] = __builtin_amdgcn_ds_read_tr16_b64_v4i16((LAS v4i16_t*)(vb + (16 * g + 8) * 72 + 32 * d0)); }
    f32x16 p0, p1;
    bf16x8 ab0, ab1;
    if (modeB) {
        const u32x2 t0 = tsp[kb0 + r32], t1 = tsp[kb0 + 32 + r32];
        ab0 = __builtin_bit_cast(bf16x8, (u32x4){t0.x, t0.y, 0x3F803F80u, 0u}); ab1 = __builtin_bit_cast(bf16x8, (u32x4){t1.x, t1.y, 0x3F803F80u, 0u});
#pragma unroll
        for (int r = 0; r < 16; ++r) { p0[r] = 0.f; p1[r] = 0.f; }
    } else {
        if (qw - (kb0 + 63) >= 128) { const float c = tab[256];
#pragma unroll
            for (int r = 0; r < 16; ++r) { p0[r] = c; p1[r] = c; } }
        else {
            const LAS float* R = tab + 272 + (191 - (qw - kb0) - r32 + 4 * hi);
#pragma unroll
            for (int r = 0; r < 16; ++r) { p0[r] = R[crow(r, 0)]; p1[r] = R[32 + crow(r, 0)]; } }
    }
    if (modeB) { p0 = __builtin_amdgcn_mfma_f32_32x32x16_bf16(ab0, bq, p0, 0, 0, 0); p1 = __builtin_amdgcn_mfma_f32_32x32x16_bf16(ab1, bq, p1, 0, 0, 0); }
#pragma unroll
    for (int d0 = 0; d0 < 4; ++d0) {
        p0 = __builtin_amdgcn_mfma_f32_32x32x16_bf16(kf0[d0], qr[d0], p0, 0, 0, 0);
        p1 = __builtin_amdgcn_mfma_f32_32x32x16_bf16(kf1[d0], qr[d0], p1, 0, 0, 0);
    }
    if (modeB && kb0 + 63 > qw) {
#pragma unroll
        for (int r = 0; r < 16; ++r) { const int kk = kb0 + crow(r, hi); if (kk > qa) p0[r] = NEGB; if (kk + 32 > qa) p1[r] = NEGB; } }
    float sum = 0.f;
#pragma unroll
    for (int r = 0; r < 16; ++r) { p0[r] = fast_exp2(p0[r]); p1[r] = fast_exp2(p1[r]); sum += p0[r] + p1[r]; }
    lrun += sum;
    bf16x8 pa[4];
    pa[0] = pack8(p0[0], p0[1], p0[2], p0[3], p0[4], p0[5], p0[6], p0[7]); pa[1] = pack8(p0[8], p0[9], p0[10], p0[11], p0[12], p0[13], p0[14], p0[15]);
    pa[2] = pack8(p1[0], p1[1], p1[2], p1[3], p1[4], p1[5], p1[6], p1[7]); pa[3] = pack8(p1[8], p1[9], p1[10], p1[11], p1[12], p1[13], p1[14], p1[15]);
#pragma unroll
    for (int g = 0; g < 4; ++g) {
#pragma unroll
        for (int d0 = 0; d0 < 2; ++d0) {
            const v4i16_t lo = vlo[2 * g + d0], up = vup[2 * g + d0];
            const bf16x8 vf = (bf16x8){lo[0], lo[1], lo[2], lo[3], up[0], up[1], up[2], up[3]};
            if (d0 == 0) o0 = __builtin_amdgcn_mfma_f32_32x32x16_bf16(pa[g], vf, o0, 0, 0, 0);
            else         o1 = __builtin_amdgcn_mfma_f32_32x32x16_bf16(pa[g], vf, o1, 0, 0, 0);
        }
    }
}
__device__ __forceinline__ void attn_bias_init(f32x16& p0, f32x16& p1, const LAS float* tab, const bool modeB, const int kb0, const int qw, const int qa, const int hi) {
    if (modeB) {
#pragma unroll
        for (int rg = 0; rg < 4; ++rg) { const f32x4 c0 = *(const LAS f32x4*)(tab + kb0 + 8 * rg + 4 * hi), c1 = *(const LAS f32x4*)(tab + kb0 + 32 + 8 * rg + 4 * hi);
#pragma unroll
            for (int i = 0; i < 4; ++i) { p0[4 * rg + i] = c0[i]; p1[4 * rg + i] = c1[i]; } }
    } else if (qw - (kb0 + 63) >= 128) { const float c = tab[256];
#pragma unroll
        for (int r = 0; r < 16; ++r) { p0[r] = c; p1[r] = c; }
    } else {
#pragma unroll
        for (int r = 0; r < 16; ++r) { const int rel = qa - (kb0 + crow(r, hi)); int i0 = rel < -128 ? -128 : rel; i0 = i0 > 128 ? 128 : i0; int i1 = rel - 32 < -128 ? -128 : rel - 32; i1 = i1 > 128 ? 128 : i1;
            p0[r] = tab[i0 + 128]; p1[r] = tab[i1 + 128]; }
    }
}
__device__ __forceinline__ void attn_softmax_pv(f32x16& p0, f32x16& p1, const LAS bf16_t* Vt, LAS float* wsf, const int lane, f32x16& o0, f32x16& o1, float& mrun, float& lrun) {
    const int r32 = lane & 31, hi = lane >> 5;
    float mx = fmaxf(p0[0], p1[0]);
#pragma unroll
    for (int r = 1; r < 16; ++r) mx = fmaxf(mx, fmaxf(p0[r], p1[r]));
    mx = fmaxf(mx, __shfl_xor(mx, 32));
    const float mnew = fmaxf(mrun, mx), alpha = fast_exp2(mrun - mnew); mrun = mnew;
    wsf[r32] = alpha;
    float sum = 0.f;
#pragma unroll
    for (int r = 0; r < 16; ++r) { p0[r] = fast_exp2(p0[r] - mnew); p1[r] = fast_exp2(p1[r] - mnew); sum += p0[r] + p1[r]; }
    lrun = lrun * alpha + sum;
#pragma unroll
    for (int rg = 0; rg < 4; ++rg) { const f32x4 f = *(const LAS f32x4*)(wsf + 8 * rg + 4 * hi);
#pragma unroll
        for (int i = 0; i < 4; ++i) { o0[4 * rg + i] *= f[i]; o1[4 * rg + i] *= f[i]; } }
    bf16x8 pa[4];
    pa[0] = pack8(p0[0], p0[1], p0[2], p0[3], p0[4], p0[5], p0[6], p0[7]); pa[1] = pack8(p0[8], p0[9], p0[10], p0[11], p0[12], p0[13], p0[14], p0[15]);
    pa[2] = pack8(p1[0], p1[1], p1[2], p1[3], p1[4], p1[5], p1[6], p1[7]); pa[3] = pack8(p1[8], p1[9], p1[10], p1[11], p1[12], p1[13], p1[14], p1[15]);
    const LAS bf16_t* vb = Vt + (4 * hi + ((lane & 15) >> 2)) * 72 + 16 * ((lane >> 4) & 1) + 4 * (lane & 3);
#pragma unroll
    for (int g = 0; g < 4; ++g) {
#pragma unroll
        for (int d0 = 0; d0 < 2; ++d0) {
            const v4i16_t lo = __builtin_amdgcn_ds_read_tr16_b64_v4i16((LAS v4i16_t*)(vb + (16 * g) * 72 + 32 * d0));
            const v4i16_t up = __builtin_amdgcn_ds_read_tr16_b64_v4i16((LAS v4i16_t*)(vb + (16 * g + 8) * 72 + 32 * d0));
            const bf16x8 vf = (bf16x8){lo[0], lo[1], lo[2], lo[3], up[0], up[1], up[2], up[3]};
            if (d0 == 0) o0 = __builtin_amdgcn_mfma_f32_32x32x16_bf16(pa[g], vf, o0, 0, 0, 0);
            else         o1 = __builtin_amdgcn_mfma_f32_32x32x16_bf16(pa[g], vf, o1, 0, 0, 0);
        }
    }
}
__device__ __forceinline__ void attn_pair(const LAS bf16_t* Kt, const LAS bf16_t* Vt, const bf16x8 (&qr)[4], const LAS float* tab, LAS float* wsf, const bool modeB, const int kb0, const int qw,
                                          const int lane, f32x16& o0, f32x16& o1, float& mrun, float& lrun) {
    const int r32 = lane & 31, hi = lane >> 5, qa = qw + r32;
    f32x16 a0, a1, b0, b1;
    attn_bias_init(a0, a1, tab, modeB, kb0, qw, qa, hi); attn_bias_init(b0, b1, tab, modeB, kb0 + 64, qw, qa, hi);
#pragma unroll
    for (int d0 = 0; d0 < 4; ++d0) {
        const LAS bf16_t* kp = Kt + r32 * 72 + d0 * 16 + hi * 8;
        const bf16x8 k0 = *(const LAS bf16x8*)(kp), k1 = *(const LAS bf16x8*)(kp + 32 * 72), k2 = *(const LAS bf16x8*)(kp + 64 * 72), k3 = *(const LAS bf16x8*)(kp + 96 * 72);
        a0 = __builtin_amdgcn_mfma_f32_32x32x16_bf16(k0, qr[d0], a0, 0, 0, 0); a1 = __builtin_amdgcn_mfma_f32_32x32x16_bf16(k1, qr[d0], a1, 0, 0, 0);
        b0 = __builtin_amdgcn_mfma_f32_32x32x16_bf16(k2, qr[d0], b0, 0, 0, 0); b1 = __builtin_amdgcn_mfma_f32_32x32x16_bf16(k3, qr[d0], b1, 0, 0, 0);
    }
    attn_softmax_pv(a0, a1, Vt, wsf, lane, o0, o1, mrun, lrun);
    attn_softmax_pv(b0, b1, Vt + 64 * 72, wsf, lane, o0, o1, mrun, lrun);
}
__device__ __forceinline__ void attn_unit(const Args& a, LAS unsigned char* lds, const bool modeB, int bh, int wave) {
    const int lane = lane_id_fresh(), tid = wave * 64 + lane;
    unsigned char* ws = a.ws;
    const int b = bh >> 3, h = bh & 7, r32 = lane & 31, hi = lane >> 5;
    const size_t hb = (size_t)(b * 8 + h) * 2048 * 64; const bf16_t* base = (const bf16_t*)(ws + WS_QKVP) + (modeB ? 3 : 0) * PSTRIDE;
    const bf16_t* Q = base + hb; const bf16_t* K = base + PSTRIDE + hb; const bf16_t* V = base + 2 * PSTRIDE + hb;
    const size_t orow0 = (size_t)b * 2048;
    const int colbase = (modeB ? 512 : 0) + h * 64;
    LAS bf16_t* Ks = (LAS bf16_t*)(lds + A_KS); LAS bf16_t* Vs = (LAS bf16_t*)(lds + A_VS);
    LAS float* tab = (LAS float*)(lds + A_TAB); LAS float* wsf = (LAS float*)(lds + A_WSF) + wave * 64; LAS float* scanw = (LAS float*)(lds + A_SCAN); LAS u32x2* tsp = (LAS u32x2*)(lds + A_TSP);
    __syncthreads();
    if (modeB) {
        const int k0 = tid * 4;
        const float* lf0 = a.out + O_LF_P + (size_t)b * 2048 * 8 + h;
        float v0 = lf0[(size_t)k0 * 8], v1 = lf0[(size_t)(k0 + 1) * 8], v2 = lf0[(size_t)(k0 + 2) * 8], v3 = lf0[(size_t)(k0 + 3) * 8];
        const float loc = (v0 + v1) + (v2 + v3);
        float inc = loc;
#pragma unroll
        for (int o = 1; o < 64; o <<= 1) { const float y = __int_as_float(__builtin_amdgcn_ds_bpermute(((lane - o) & 63) << 2, __float_as_int(inc))); if (lane >= o) inc += y; }
        if (lane == 63) scanw[wave] = inc;
        __syncthreads();
        float run = inc - loc;
        for (int w = 0; w < wave; ++w) run += scanw[w];
        float tv[4]; run += v0; tv[0] = -run * LOG2E; run += v1; tv[1] = -run * LOG2E; run += v2; tv[2] = -run * LOG2E; run += v3; tv[3] = -run * LOG2E;
#pragma unroll
        for (int i = 0; i < 4; ++i) { tab[k0 + i] = tv[i]; unsigned hh, mm, ll; split3(tv[i], hh, mm, ll); tsp[k0 + i] = (u32x2){hh | (mm << 16), ll | 0x3F800000u}; }
    } else {
        for (int i = tid; i < 257; i += 512) tab[i] = a.in[16][h * 257 + i] * LOG2E;
    }
    __syncthreads();
    const float bqk = qk_bound(ws, modeB, lane);
    const int srow = tid >> 3, sch = tid & 7;
    for (int qb = 0; qb < 8; ++qb) {
        const int q0 = qb * 256, qw = q0 + 32 * wave;
        int tlo, thi, blo, bhi;
        if (modeB) { tlo = 0; thi = (qw + 31) >> 6; blo = 0; bhi = (q0 + 255) >> 6; }
        else { const int c = qw >> 6; tlo = c > 8 ? c - 8 : 0; thi = c; const int c0 = q0 >> 6; blo = c0 > 8 ? c0 - 8 : 0; bhi = (q0 + 224) >> 6; }
        const int Tlo = blo >> 1, Thi = bhi >> 1;
        bf16x8 qr[4];
#pragma unroll
        for (int d0 = 0; d0 < 4; ++d0) qr[d0] = *(const bf16x8*)(Q + (size_t)(qw + r32) * 64 + d0 * 16 + hi * 8);
        float mrun = (modeB ? tab[qw + r32] : 0.f) + bqk, lrun = 0.f; f32x16 o0 = {}, o1 = {};
        bf16x8 bq;
        { unsigned hh, mm, ll; split3(-mrun, hh, mm, ll);
          const u32x4 w = hi == 0 ? (u32x4){0x3F803F80u, 0x3F80u | (hh << 16), mm | (ll << 16), 0u} : (u32x4){0u, 0u, 0u, 0u}; bq = __builtin_bit_cast(bf16x8, w); }
        u32x4 kr0, kr1, vr0, vr1;
        { const size_t ro = (size_t)(128 * Tlo + srow) * 64 + sch * 8;
          kr0 = *(const u32x4*)(K + ro); kr1 = *(const u32x4*)(K + ro + 64 * 64); vr0 = *(const u32x4*)(V + ro); vr1 = *(const u32x4*)(V + ro + 64 * 64); }
        *(LAS u32x4*)(Ks + srow * 72 + sch * 8) = kr0; *(LAS u32x4*)(Ks + (64 + srow) * 72 + sch * 8) = kr1;
        *(LAS u32x4*)(Vs + srow * 72 + sch * 8) = vr0; *(LAS u32x4*)(Vs + (64 + srow) * 72 + sch * 8) = vr1;
        __syncthreads();
        for (int T = Tlo; T <= Thi; ++T) {
            const int cur = (T - Tlo) & 1;
            if (T < Thi) { const size_t ro = (size_t)(128 * (T + 1) + srow) * 64 + sch * 8;
                kr0 = *(const u32x4*)(K + ro); kr1 = *(const u32x4*)(K + ro + 64 * 64); vr0 = *(const u32x4*)(V + ro); vr1 = *(const u32x4*)(V + ro + 64 * 64); }
            const LAS bf16_t* Kt = Ks + cur * KVT; const LAS bf16_t* Vt = Vs + cur * KVT;
            if (2 * T >= tlo && 2 * T <= thi) attn_tile(Kt, Vt, qr, tab, wsf, modeB, 128 * T, qw, lane, o0, o1, mrun, lrun, bq, tsp);
            if (2 * T + 1 >= tlo && 2 * T + 1 <= thi) attn_tile(Kt + 64 * 72, Vt + 64 * 72, qr, tab, wsf, modeB, 128 * T + 64, qw, lane, o0, o1, mrun, lrun, bq, tsp);
            if (T < Thi) { LAS bf16_t* Kn = Ks + (cur ^ 1) * KVT; LAS bf16_t* Vn = Vs + (cur ^ 1) * KVT;
                *(LAS u32x4*)(Kn + srow * 72 + sch * 8) = kr0; *(LAS u32x4*)(Kn + (64 + srow) * 72 + sch * 8) = kr1;
                *(LAS u32x4*)(Vn + srow * 72 + sch * 8) = vr0; *(LAS u32x4*)(Vn + (64 + srow) * 72 + sch * 8) = vr1; }
            __syncthreads();
        }
        {
            float lt; { const auto rr_ = __builtin_amdgcn_permlane32_swap(__float_as_uint(lrun), __float_as_uint(lrun), false, false); lt = __uint_as_float(rr_[0]) + __uint_as_float(rr_[1]); }
            if (hi == 0) wsf[r32] = fast_rcp(lt);
            asm volatile("s_waitcnt lgkmcnt(0)" ::: "memory");
            bf16_t* Ob = (bf16_t*)(ws + WS_O) + (orow0 + qw) * 1024 + colbase + r32;
#pragma unroll
            for (int r = 0; r < 16; ++r) { const int rr = crow(r, hi); const float f = wsf[rr];
                Ob[(size_t)rr * 1024] = (bf16_t)(cvt_pk_bf16(o0[r] * f, 0.f) & 0xffffu); Ob[(size_t)rr * 1024 + 32] = (bf16_t)(cvt_pk_bf16(o1[r] * f, 0.f) & 0xffffu); }
        }
    }
}

constexpr int A2_KV = 0, A2_TAB = 73728, A2_WSF = 78080;
__device__ __forceinline__ void attn_unit_A2(const Args& a, LAS unsigned char* lds, int u, int wave) {
    const int lane = lane_id_fresh(), tid = wave * 64 + lane;
    unsigned char* ws = a.ws;
    const int part = u & 1, bhp = u >> 1, b = bhp >> 2, g = wave >> 2, h = 2 * (bhp & 3) + g, wg = wave & 3, r32 = lane & 31, hi = lane >> 5;
    const size_t hb = (size_t)(b * 8 + h) * 2048 * 64; const bf16_t* base = (const bf16_t*)(ws + WS_QKVP);
    const bf16_t* Q = base + hb; const bf16_t* K = base + PSTRIDE + hb; const bf16_t* V = base + 2 * PSTRIDE + hb;
    const size_t orow0 = (size_t)b * 2048; const int colbase = h * 64;
    LAS bf16_t* Kg = (LAS bf16_t*)(lds + A2_KV + g * 36864); LAS bf16_t* Vg = Kg + 2 * 4608;
    LAS float* tab = (LAS float*)(lds + A2_TAB) + g * 544; LAS float* wsf = (LAS float*)(lds + A2_WSF) + wave * 64;
    __syncthreads();
    {
        const int gt = tid & 255;
        const float off = qk_bound(ws, false, lane) + *(volatile const float*)((const float*)(ws + WS_GAINS) + 264 + h) * LOG2E;
        tab[gt] = a.in[16][h * 257 + gt] * LOG2E - off; if (gt == 0) tab[256] = a.in[16][h * 257 + 256] * LOG2E - off;
        if (gt < 255) { const int rel = 191 - gt; tab[272 + gt] = a.in[16][h * 257 + (rel > 128 ? 128 : rel) + 128] * LOG2E - off; }
    }
    __syncthreads();
    const int gt = tid & 255, srow = gt >> 2, sc = (gt & 3) * 16;
    for (int qb = part; qb < 16; qb += 2) {
        const int q0 = qb * 128, qw = q0 + 32 * wg, c = qw >> 6;
        const int tlo = c > 8 ? c - 8 : 0, thi = c, blo = 2 * qb > 8 ? 2 * qb - 8 : 0, bhi = 2 * qb + 1;
        bf16x8 qr[4];
#pragma unroll
        for (int d0 = 0; d0 < 4; ++d0) qr[d0] = *(const bf16x8*)(Q + (size_t)(qw + r32) * 64 + d0 * 16 + hi * 8);
        float mrun = 0.f, lrun = 0.f; f32x16 o0 = {}, o1 = {};
        u32x4 kr0, kr1, vr0, vr1;
        { const size_t ro = (size_t)(64 * blo + srow) * 64 + sc;
          kr0 = *(const u32x4*)(K + ro); kr1 = *(const u32x4*)(K + ro + 8); vr0 = *(const u32x4*)(V + ro); vr1 = *(const u32x4*)(V + ro + 8); }
        *(LAS u32x4*)(Kg + srow * 72 + sc) = kr0; *(LAS u32x4*)(Kg + srow * 72 + sc + 8) = kr1;
        *(LAS u32x4*)(Vg + srow * 72 + sc) = vr0; *(LAS u32x4*)(Vg + srow * 72 + sc + 8) = vr1;
        __syncthreads();
        for (int t = blo; t <= bhi; ++t) {
            const int cur = (t - blo) & 1;
            if (t < bhi) { const size_t ro = (size_t)(64 * (t + 1) + srow) * 64 + sc;
                kr0 = *(const u32x4*)(K + ro); kr1 = *(const u32x4*)(K + ro + 8); vr0 = *(const u32x4*)(V + ro); vr1 = *(const u32x4*)(V + ro + 8); }
            if (t >= tlo && t <= thi) attn_tile(Kg + cur * 4608, Vg + cur * 4608, qr, tab, wsf, false, 64 * t, qw, lane, o0, o1, mrun, lrun);
            if (t < bhi) { LAS bf16_t* Kn = Kg + (cur ^ 1) * 4608; LAS bf16_t* Vn = Vg + (cur ^ 1) * 4608;
                *(LAS u32x4*)(Kn + srow * 72 + sc) = kr0; *(LAS u32x4*)(Kn + srow * 72 + sc + 8) = kr1;
                *(LAS u32x4*)(Vn + srow * 72 + sc) = vr0; *(LAS u32x4*)(Vn + srow * 72 + sc + 8) = vr1; }
            __syncthreads();
        }
        {
            float lt; { const auto rr_ = __builtin_amdgcn_permlane32_swap(__float_as_uint(lrun), __float_as_uint(lrun), false, false); lt = __uint_as_float(rr_[0]) + __uint_as_float(rr_[1]); }
            if (hi == 0) wsf[r32] = fast_rcp(lt);
            asm volatile("s_waitcnt lgkmcnt(0)" ::: "memory");
            bf16_t* Ob = (bf16_t*)(ws + WS_O) + (orow0 + qw) * 1024 + colbase + r32;
#pragma unroll
            for (int r = 0; r < 16; ++r) { const int rr = crow(r, hi); const float f = wsf[rr];
                Ob[(size_t)rr * 1024] = (bf16_t)(cvt_pk_bf16(o0[r] * f, 0.f) & 0xffffu); Ob[(size_t)rr * 1024 + 32] = (bf16_t)(cvt_pk_bf16(o1[r] * f, 0.f) & 0xffffu); }
        }
    }
}

constexpr int S_KV = 0, S_TAB = 73728, S_WSF = 90368, S_SCAN = 92416;
__device__ __forceinline__ void samp_tile(const LAS bf16_t* Kw, const bf16x8 (&qr)[4], const LAS bf16_t* Vw, const LAS float* tab, LAS float* wsf, const bool modeB, const bool isnew, const int t0,
                                          const int lane, f32x16& o0, f32x16& o1, float& mrun, float& lrun) {
    const int r32 = lane & 31, hi = lane >> 5;
    f32x16 p = {};
#pragma unroll
    for (int d0 = 0; d0 < 4; ++d0) { const bf16x8 kf = *(const LAS bf16x8*)(Kw + r32 * 72 + d0 * 16 + hi * 8); p = __builtin_amdgcn_mfma_f32_32x32x16_bf16(kf, qr[d0], p, 0, 0, 0); }
    if (modeB) {
#pragma unroll
        for (int rg = 0; rg < 4; ++rg) { const f32x4 c0 = *(const LAS f32x4*)(tab + t0 + 8 * rg + 4 * hi);
#pragma unroll
            for (int i = 0; i < 4; ++i) p[4 * rg + i] += c0[i]; }
        if (isnew) {
#pragma unroll
            for (int r = 0; r < 16; ++r) if (crow(r, hi) > r32) p[r] = NEGB; }
    } else {
        if (512 - (t0 + 31) >= 128) { const float c = tab[256];
#pragma unroll
            for (int r = 0; r < 16; ++r) p[r] += c; }
        else {
#pragma unroll
            for (int r = 0; r < 16; ++r) { const int rel = 512 + r32 - (t0 + crow(r, hi)); int i0 = rel < -128 ? -128 : rel; i0 = i0 > 128 ? 128 : i0; p[r] += tab[i0 + 128]; } }
    }
    float sum = 0.f;
#pragma unroll
    for (int r = 0; r < 16; ++r) { p[r] = fast_exp2(p[r] - mrun); sum += p[r]; }
    lrun += sum;
    bf16x8 pa[2];
    pa[0] = pack8(p[0], p[1], p[2], p[3], p[4], p[5], p[6], p[7]); pa[1] = pack8(p[8], p[9], p[10], p[11], p[12], p[13], p[14], p[15]);
    const LAS bf16_t* vb = Vw + (4 * hi + ((lane & 15) >> 2)) * 72 + 16 * ((lane >> 4) & 1) + 4 * (lane & 3);
#pragma unroll
    for (int g = 0; g < 2; ++g) {
#pragma unroll
        for (int d0 = 0; d0 < 2; ++d0) {
            const v4i16_t lo = __builtin_amdgcn_ds_read_tr16_b64_v4i16((LAS v4i16_t*)(vb + (16 * g) * 72 + 32 * d0));
            const v4i16_t up = __builtin_amdgcn_ds_read_tr16_b64_v4i16((LAS v4i16_t*)(vb + (16 * g + 8) * 72 + 32 * d0));
            const bf16x8 vf = (bf16x8){lo[0], lo[1], lo[2], lo[3], up[0], up[1], up[2], up[3]};
            if (d0 == 0) o0 = __builtin_amdgcn_mfma_f32_32x32x16_bf16(pa[g], vf, o0, 0, 0, 0);
            else         o1 = __builtin_amdgcn_mfma_f32_32x32x16_bf16(pa[g], vf, o1, 0, 0, 0);
        }
    }
}
__device__ __forceinline__ void samp_unit(const Args& a, LAS unsigned char* lds, const bool modeB, int bh, int wave) {
    const int lane = lane_id_fresh(), tid = wave * 64 + lane;
    unsigned char* ws = a.ws;
    const int b = bh >> 3, h = bh & 7, r32 = lane & 31, hi = lane >> 5;
    const int P = modeB ? 4096 : 512, ttot = P + 32;
    const float* Kc = a.in[modeB ? 4 : 2] + (size_t)b * P * 512 + h * 64;
    const float* Vc = a.in[modeB ? 5 : 3] + (size_t)b * P * 512 + h * 64;
    const bf16_t* Qn = (const bf16_t*)(ws + (modeB ? WS_QBS : WS_QAS)) + (size_t)(b * 8 + h) * 2048;
    const bf16_t* Kn = (const bf16_t*)(ws + (modeB ? WS_KBN : WS_KAN)) + (size_t)(b * 8 + h) * 2048;
    const bf16_t* Vn = (const bf16_t*)(ws + (modeB ? WS_VBN : WS_VAN)) + (size_t)(b * 8 + h) * 2048;
    LAS bf16_t* Kw = (LAS bf16_t*)(lds + S_KV) + wave * 4608; LAS bf16_t* Vw = Kw + 2304;
    LAS float* tab = (LAS float*)(lds + S_TAB); LAS float* wsf = (LAS float*)(lds + S_WSF) + wave * 64; LAS float* scanw = (LAS float*)(lds + S_SCAN);
    __syncthreads();
    if (modeB) {
        const int per = (ttot + 511) >> 9, k0 = tid * per;
        const float* lf0 = a.in[6] + (size_t)b * 4096 * 8 + h; const float* lf1 = a.out + O_LF_S + (size_t)b * 32 * 8 + h;
        float loc = 0.f;
        for (int i = 0; i < per; ++i) { const int k = k0 + i; if (k < ttot) loc += (k < P) ? lf0[(size_t)k * 8] : lf1[(size_t)(k - P) * 8]; }
        float inc = loc;
#pragma unroll
        for (int o = 1; o < 64; o <<= 1) { const float y = __int_as_float(__builtin_amdgcn_ds_bpermute(((lane - o) & 63) << 2, __float_as_int(inc))); if (lane >= o) inc += y; }
        if (lane == 63) scanw[wave] = inc;
        __syncthreads();
        float run = inc - loc;
        for (int w = 0; w < wave; ++w) run += scanw[w];
        for (int i = 0; i < per; ++i) { const int k = k0 + i; if (k < ttot) { run += (k < P) ? lf0[(size_t)k * 8] : lf1[(size_t)(k - P) * 8]; tab[k] = -run * LOG2E; } }
    } else {
        const float off = qk_bound(ws, false, lane) + *(volatile const float*)((const float*)(ws + WS_GAINS) + 264 + h) * LOG2E;
        for (int i = tid; i < 257; i += 512) tab[i] = a.in[16][h * 257 + i] * LOG2E - off;
    }
    __syncthreads();
    bf16x8 qr[4];
#pragma unroll
    for (int d0 = 0; d0 < 4; ++d0) qr[d0] = *(const bf16x8*)(Qn + r32 * 64 + d0 * 16 + hi * 8);
    float mrun = modeB ? tab[P + r32] + qk_bound(ws, true, lane) : 0.f, lrun = 0.f; f32x16 o0 = {}, o1 = {};
    const int ntile = P >> 5;
    f32x4 rk[8], rv[8];
    const size_t lo_off = (size_t)(lane >> 4) * 512 + 4 * (lane & 15);
    const int lw = (lane >> 4) * 72 + 4 * (lane & 15);
    int t = wave;
    {
#pragma unroll
        for (int j = 0; j < 8; ++j) { rk[j] = __builtin_nontemporal_load((const f32x4*)(Kc + (size_t)t * 16384 + lo_off + (size_t)j * 2048)); rv[j] = __builtin_nontemporal_load((const f32x4*)(Vc + (size_t)t * 16384 + lo_off + (size_t)j * 2048)); }
    }
    for (; t < ntile; t += 8) {
#pragma unroll
        for (int j = 0; j < 8; ++j) { u32x2 wk, wv; wk.x = cvt_pk_bf16(rk[j][0], rk[j][1]); wk.y = cvt_pk_bf16(rk[j][2], rk[j][3]); wv.x = cvt_pk_bf16(rv[j][0], rv[j][1]); wv.y = cvt_pk_bf16(rv[j][2], rv[j][3]);
            *(LAS u32x2*)(Kw + lw + j * 288) = wk; *(LAS u32x2*)(Vw + lw + j * 288) = wv; }
        if (t + 8 < ntile) {
#pragma unroll
            for (int j = 0; j < 8; ++j) { rk[j] = __builtin_nontemporal_load((const f32x4*)(Kc + (size_t)(t + 8) * 16384 + lo_off + (size_t)j * 2048)); rv[j] = __builtin_nontemporal_load((const f32x4*)(Vc + (size_t)(t + 8) * 16384 + lo_off + (size_t)j * 2048)); }
        }
        samp_tile(Kw, qr, Vw, tab, wsf, modeB, false, 32 * t, lane, o0, o1, mrun, lrun);
    }
    if (wave == 0) {
#pragma unroll
        for (int j = 0; j < 4; ++j) { const int row = (lane >> 3) + 8 * j, col = 8 * (lane & 7);
            *(LAS bf16x8*)(Kw + row * 72 + col) = *(const bf16x8*)(Kn + row * 64 + col); *(LAS bf16x8*)(Vw + row * 72 + col) = *(const bf16x8*)(Vn + row * 64 + col); }
        samp_tile(Kw, qr, Vw, tab, wsf, modeB, true, P, lane, o0, o1, mrun, lrun);
    }
    {
        float lt; { const auto rr_ = __builtin_amdgcn_permlane32_swap(__float_as_uint(lrun), __float_as_uint(lrun), false, false); lt = __uint_as_float(rr_[0]) + __uint_as_float(rr_[1]); }
        LAS float* oc = (LAS float*)(lds + S_KV + wave * 9216); LAS float* ml = oc + 2048;
#pragma unroll
        for (int r = 0; r < 16; ++r) { oc[crow(r, hi) * 64 + r32] = o0[r]; oc[crow(r, hi) * 64 + 32 + r32] = o1[r]; }
        if (hi == 0) { ml[2 * r32] = mrun; ml[2 * r32 + 1] = lt; }
    }
    __syncthreads();
    {
        const int q = tid >> 4, d4 = (tid & 15) * 4;
        const LAS float* mlb = (const LAS float*)(lds + S_KV) + 2048 + 2 * q; const LAS float* ocb = (const LAS float*)(lds + S_KV) + q * 64 + d4;
        float M = mlb[0];
#pragma unroll
        for (int w = 1; w < 8; ++w) M = fmaxf(M, mlb[w * 2304]);
        f32x4 num = {0.f, 0.f, 0.f, 0.f}; float den = 0.f;
#pragma unroll
        for (int w = 0; w < 8; ++w) { const float f = fast_exp2(mlb[w * 2304] - M); den += f * mlb[w * 2304 + 1]; num += *(const LAS f32x4*)(ocb + w * 2304) * f; }
        const float inv = 1.0f / den;
        u32x2 w2; w2.x = cvt_pk_bf16(num[0] * inv, num[1] * inv); w2.y = cvt_pk_bf16(num[2] * inv, num[3] * inv);
        *(u32x2*)((bf16_t*)(ws + WS_O) + ((size_t)MP + b * 32 + q) * 1024 + (modeB ? 512 : 0) + h * 64 + d4) = w2;
    }
}

#define XB_TMO      128
#define XB_XCNT(j)  (256  + 64 * (j))
#define XB_XSUB(j)  (1280 + 64 * (j))
#define XB_XGEN(j)  (2304 + 64 * (j))
#define XB_TOP      3328
#define XB_TOPGEN   3392
#define XB_SPIN_CAP (1u << 20)
__device__ __forceinline__ unsigned xb_ld(unsigned* p)              { return __hip_atomic_load(p, __ATOMIC_RELAXED, __HIP_MEMORY_SCOPE_AGENT); }
__device__ __forceinline__ unsigned xb_add(unsigned* p, unsigned v) { return __hip_atomic_fetch_add(p, v, __ATOMIC_RELAXED, __HIP_MEMORY_SCOPE_AGENT); }
__device__ __forceinline__ unsigned xb_xcc_id() { return (unsigned)__builtin_amdgcn_s_getreg((3 << 11) | 20) & 0xFu; }
#define XB_SPIN(cond, bar) do { unsigned _sp = 0; while (cond) { __builtin_amdgcn_s_sleep(1); \
    if ((++_sp & 255u) == 0u) { if (xb_ld(&(bar)[XB_TMO])) break; if (_sp > XB_SPIN_CAP) { atomicAdd(&(bar)[XB_TMO], 1u); break; } } } } while (0)
__device__ __forceinline__ void xcd_barrier_complete(unsigned* bar, unsigned x, unsigned G, unsigned& nloc, unsigned& nx) {
    unsigned sum, cnt, mine, sp = 0u;
    for (;;) {
        sum = 0u; cnt = 0u; mine = 0u;
#pragma unroll
        for (unsigned j = 0; j < 16; ++j) { const unsigned c = xb_ld(&bar[XB_XCNT(j)]); sum += c; cnt += (c > 0u) ? 1u : 0u; mine = (j == x) ? c : mine; }
        if (sum == G) break;
        __builtin_amdgcn_s_sleep(1);
        if ((++sp & 255u) == 0u) { if (xb_ld(&bar[XB_TMO])) break; if (sp > XB_SPIN_CAP) { atomicAdd(&bar[XB_TMO], 1u); break; } }
    }
    nloc = mine > 0u ? mine : 1u; nx = cnt > 0u ? cnt : 1u;
}
__device__ __forceinline__ void grid_bar(unsigned* bar, volatile LAS unsigned* st, unsigned x, unsigned G, int wave) {
    asm volatile("s_waitcnt vmcnt(0)" ::: "memory");
    __syncthreads();
    if (wave == 0 && lane_id_fresh() == 0) {
        __builtin_amdgcn_s_waitcnt(0);
        unsigned nloc = st[0], nx = st[1];
        if (nloc == 0u) { xcd_barrier_complete(bar, x, G, nloc, nx); st[0] = nloc; st[1] = nx; }
        const unsigned old = xb_add(&bar[XB_XSUB(x)], 1u);
        const unsigned gen = old / nloc;
        if (old + 1u == (gen + 1u) * nloc) {
            __builtin_amdgcn_fence(__ATOMIC_RELEASE, "agent");
            asm volatile("s_waitcnt vmcnt(0)" ::: "memory");
            const unsigned og = xb_add(&bar[XB_TOP], 1u);
            const unsigned tg = og / nx;
            if (og + 1u == (tg + 1u) * nx) xb_add(&bar[XB_TOPGEN], 1u);
            else XB_SPIN(xb_ld(&bar[XB_TOPGEN]) == tg, bar);
            __builtin_amdgcn_fence(__ATOMIC_ACQUIRE, "agent");
            xb_add(&bar[XB_XGEN(x)], 1u);
            asm volatile("s_waitcnt vmcnt(0)" ::: "memory");
        } else {
            XB_SPIN(xb_ld(&bar[XB_XGEN(x)]) == gen, bar);
            __builtin_amdgcn_fence(__ATOMIC_ACQUIRE, "agent");
            asm volatile("s_waitcnt vmcnt(0)" ::: "memory");
        }
    }
    __syncthreads();
}

__global__ void __launch_bounds__(512, 2) mk_fwd(Args a) {
    extern __shared__ __attribute__((aligned(16))) unsigned char lds_raw[];
    LAS unsigned char* lds = (LAS unsigned char*)lds_raw;
    const int wave = __builtin_amdgcn_readfirstlane((int)threadIdx.x >> 6);
    unsigned char* ws = a.ws;
    const int lo = a.ph_lo, hi = a.ph_hi, G = gridDim.x, c = blockIdx.x;
#if MK_N_LAUNCHES == 1
    if (lo < 0) cg::this_grid().sync();
    volatile LAS unsigned* xb_st = (volatile LAS unsigned*)(lds + (LDS_BYTES - 16));
    const unsigned xb_x = xb_xcc_id();
    if (wave == 0 && lane_id_fresh() == 0) { xb_st[0] = 0u; xb_st[1] = 0u; (void)xb_add(&((unsigned*)ws)[XB_XCNT(xb_x)], 1u); }
    __syncthreads();
#define SEAM(k) do { if (lo <= (k) && (k) + 1 < hi) grid_bar((unsigned*)ws, xb_st, xb_x, (unsigned)G, wave); } while (0)
#else
#define SEAM(k) do { } while (0)
#endif
#define IN(k) (lo <= (k) && (k) < hi)
    if (IN(0)) { phase0(a, lds, wave); SEAM(0); }
    if (IN(1)) {
        pg8::Gemm g{(const bf16_t*)(ws + WS_XB), (const bf16_t*)(ws + WS_WQKV), MT, NQKV, 1024}; pg8::StaticOrder S; S.init(MT, NQKV, G, c);
        EpiQKV E{(const float*)(ws + WS_RSTD0), (const float*)(ws + WS_GAINS), ws, a.out};
        pg8::gemm_phase<EpiQKV, pg8::StaticOrder, true, true>(lds, g, S, E, wave);
        { int rk_, cn_; shadow_share((MT / 256) * (NQKV / 256), G, c, rk_, cn_); if (cn_ > 0) tr_set(a, lds, wave, lane_id_fresh(), 1, rk_ * 8 + wave, cn_ * 8); }
        SEAM(1);
    }
    if (IN(2)) {
        for (int i = 0; i < 4; ++i) { const int ty = (c & 1) ? ((i + 2) & 3) : i;
            for (int bh0 = c; bh0 < 256; bh0 += G) { int bh = bh0; asm volatile("" : "+s"(bh));
                if (ty == 0) { int one = 1; asm volatile("" : "+s"(one)); attn_unit(a, lds, one != 0, bh, wave); } else if (ty == 1) attn_unit_A2(a, lds, bh, wave); else samp_unit(a, lds, ty == 2, bh, wave); } }
        SEAM(2);
    }
    if (IN(3)) {
        { pg8::Gemm g{(const bf16_t*)(ws + WS_O), (const bf16_t*)(ws + WS_WO), MT, 1024, 1024}; pg8::StaticOrder S; S.init(MT, 1024, G, c);
          EpiRes<false> E{nullptr, nullptr, (bf16_t*)(ws + WS_XB), (float*)(ws + WS_SSQ1)};
          pg8::gemm_phase<EpiRes<false>, pg8::StaticOrder, true, true>(lds, g, S, E, wave); }
        { int rk_, cn_; shadow_share((MT / 256) * 4, G, c, rk_, cn_); if (cn_ > 0) p_convert(a, (size_t)rk_ * 512 + wave * 64 + lane_id_fresh(), (size_t)cn_ * 512); }
        SEAM(3);
    }
    if (IN(4)) {
        pg8::Gemm g{(const bf16_t*)(ws + WS_XB), (const bf16_t*)(ws + WS_WGU), MT, 2 * DFF, 1024}; pg8::StaticOrder S; S.init(MT, 2 * DFF, G, c);
        EpiSwiGLU E{(const float*)(ws + WS_SSQ1), (bf16_t*)(ws + WS_H)};
        pg8::gemm_phase<EpiSwiGLU, pg8::StaticOrder, true, true>(lds, g, S, E, wave);
        { int rk_, cn_; shadow_share((MT / 256) * (2 * DFF / 256), G, c, rk_, cn_); if (cn_ > 0) tr_set(a, lds, wave, lane_id_fresh(), 2, rk_ * 8 + wave, cn_ * 8); }
        SEAM(4);
    }
    if (IN(5)) {
        pg8::Gemm g{(const bf16_t*)(ws + WS_H), (const bf16_t*)(ws + WS_WD), MT, 1024, DFF}; pg8::StaticOrder S; S.init(MT, 1024, G, c);
        EpiRes<false> E{nullptr, nullptr, (bf16_t*)(ws + WS_XB), (float*)(ws + WS_SSQ2)};
        pg8::gemm_phase<EpiRes<false>, pg8::StaticOrder, true, true>(lds, g, S, E, wave);
        {
            const int nu = (MT / 256) * 4, tailc = nu - (nu / G) * G;
            const bool split = tailc > 0 && tailc * 2 < G;
            if (!split || c >= tailc) {
                pg8::Gemm g2{(const bf16_t*)(ws + WS_PB), (const bf16_t*)(ws + WS_WPP), MT, 1024, PLE}; pg8::StaticOrder S2; S2.init(MT, 1024, split ? G - tailc : G, split ? c - tailc : c);
                EpiStore E2{(bf16_t*)(ws + WS_PP), 1024};
                pg8::gemm_phase<EpiStore, pg8::StaticOrder, true, true>(lds, g2, S2, E2, wave);
            }
        }
        SEAM(5);
    }
    if (IN(6)) {
        pg8::Gemm g{(const bf16_t*)(ws + WS_XB), (const bf16_t*)(ws + WS_WPG), MT, 1024, 1024}; pg8::StaticOrder S; S.init(MT, 1024, G, c);
        EpiPle E{(const float*)(ws + WS_SSQ2), (const bf16_t*)(ws + WS_PP), (const bf16_t*)(ws + WS_XB), a.out + O_Y};
        pg8::gemm_phase<EpiPle, pg8::StaticOrder, true, true>(lds, g, S, E, wave);
    }
#undef IN
#undef SEAM
}

extern "C" void kernel_launch(void* const* d_in, const int* in_sizes, int n_in, void* d_out, int out_size, void* d_ws, size_t ws_size, hipStream_t stream) {
    static int grid = 0;
    if (grid == 0) {
        if (n_in != 25 || (size_t)out_size != O_END || ws_size < WS_END) { fprintf(stderr, "kernel_launch: unexpected shapes: n_in %d out %d (want %zu) ws %zu (want >= %zu)\n", n_in, out_size, (size_t)O_END, ws_size, (size_t)WS_END); if (n_in != 25 || ws_size < WS_END) { grid = -1; return; } }
        int dev = 0, cus = 0, per_cu = 0;
        if (hipGetDevice(&dev) != hipSuccess || hipDeviceGetAttribute(&cus, hipDeviceAttributeMultiprocessorCount, dev) != hipSuccess) { grid = -1; return; }
        if (hipFuncSetAttribute((const void*)mk_fwd, hipFuncAttributeMaxDynamicSharedMemorySize, LDS_BYTES) != hipSuccess) { fprintf(stderr, "kernel_launch: hipFuncSetAttribute failed\n"); grid = -1; return; }
        if (hipOccupancyMaxActiveBlocksPerMultiprocessor(&per_cu, (const void*)mk_fwd, 512, LDS_BYTES) != hipSuccess || per_cu < 1) { fprintf(stderr, "kernel_launch: occupancy query says %d\n", per_cu); per_cu = 1; }
        (void)hipGetLastError();
        grid = cus * per_cu;
    }
    if (grid < 0) return;
    Args a{};
    for (int i = 0; i < 25; ++i) a.in[i] = (const float*)d_in[i];
    a.out = (float*)d_out; a.ws = (unsigned char*)d_ws;
#if MK_N_LAUNCHES == 1
    a.ph_lo = 0; a.ph_hi = 7;
    if (hipMemsetAsync(d_ws, 0, 16384, stream) != hipSuccess) { fprintf(stderr, "kernel_launch: memset failed\n"); return; }
    void* args[] = {&a};
    hipError_t e = hipLaunchCooperativeKernel((const void*)mk_fwd, dim3(grid), dim3(512), args, LDS_BYTES, stream);
    if (e != hipSuccess) fprintf(stderr, "kernel_launch: cooperative launch failed: %s (grid %d)\n", hipGetErrorString(e), grid);
#else
    for (int ph = 0; ph < 7; ++ph) { a.ph_lo = ph; a.ph_hi = ph + 1; hipLaunchKernelGGL(mk_fwd, dim3(grid), dim3(512), LDS_BYTES, stream, a); }
#endif
}
```

```cpp
#include <hip/hip_runtime.h>
#include <hip/hip_cooperative_groups.h>
#include <cstdio>
#include <cstdint>
namespace cg = cooperative_groups;
#ifndef MK_N_LAUNCHES
#define MK_N_LAUNCHES 1
#endif
namespace pg8 {
#define PG8_LAS __attribute__((address_space(3)))
typedef unsigned short bf16_t;
typedef short bf16x8 __attribute__((ext_vector_type(8)));
typedef float f32x4 __attribute__((ext_vector_type(4)));
typedef unsigned u32x4 __attribute__((ext_vector_type(4)));
constexpr int BM = 256, BK = 64, HALF = 128, HTB = HALF * BK * 2  , STAGE_BYTES = 8 * HTB, NXCD = 8, WGM = 8;

__host__ __device__ __forceinline__ int lds_byte(int r, int c) { const int st = (r >> 4) * 2 + (c >> 5), rr = r & 15, cc = c & 31, ob = rr * 64 + cc * 2; return st * 1024 + (ob ^ (((ob >> 9) & 1) << 5)); }
__host__ __device__ __forceinline__ void stage_rc(int b, int& R, int& C) { const int st = b / 1024, sb = b % 1024, swz = sb ^ (((sb >> 9) & 1) << 5); R = (st >> 1) * 16 + swz / 64; C = (st & 1) * 32 + (swz % 64) / 2; }
__host__ __device__ __forceinline__ int perm32(int rho) { const int n = rho >> 4, i = rho & 15; return 8 * (i >> 2) + 4 * n + (i & 3); }

struct Unit { int pm, pn; };
struct Gemm { const bf16_t* A; const bf16_t* Bt; int M, N, K; };

struct StaticOrder {
    int nM, nN, nwg, G, c;
    __host__ __device__ void init(int M, int N, int G_, int c_) { nM = M / BM; nN = N / BM; nwg = nM * nN; G = G_; c = c_; }
    __host__ __device__ bool next(int i, Unit& u) const {
        const long L = (long)i * G + c; if (L >= nwg) return false;
        int wgid = (int)L; { const int q = nwg / NXCD, r = nwg % NXCD, xcd = wgid % NXCD, off = wgid / NXCD; wgid = (xcd < r ? xcd * (q + 1) : r * (q + 1) + (xcd - r) * q) + off; }
        const int nig = WGM * nN, gid = wgid / nig, fm = gid * WGM, gsz = (nM - fm) < WGM ? (nM - fm) : WGM;
        u.pm = fm + ((wgid % nig) % gsz); u.pn = (wgid % nig) / gsz; return true;
    }
    __device__ __forceinline__ void a_ready(const Unit&) const {}
    __device__ __forceinline__ void done(const Unit&) const {}
};

typedef float f32x2_cv __attribute__((ext_vector_type(2))); typedef __bf16 bf16x2_cv __attribute__((ext_vector_type(2)));
__device__ __forceinline__ unsigned cvt_pk_bf16(float lo, float hi) { const f32x2_cv v = {lo, hi}; const bf16x2_cv b = __builtin_convertvector(v, bf16x2_cv); return __builtin_bit_cast(unsigned, b); }
typedef float f32x2 __attribute__((ext_vector_type(2)));
template <class Epi, class Sched, bool ALIGN_EPI = false, bool SP2 = false>
__device__ __forceinline__ void gemm_phase(PG8_LAS unsigned char* lds, const Gemm g, const Sched& S, const Epi& E, const int wid) {
    int lane_; asm volatile("v_mbcnt_lo_u32_b32 %0, -1, 0\n\tv_mbcnt_hi_u32_b32 %0, -1, %0" : "=v"(lane_));
    const int lane = lane_, tid = wid * 64 + lane, wr = wid >> 2, wc = wid & 3, fr = lane & 15, fq = lane >> 4;
    const int K = g.K, nt = K / BK;
    unsigned voffA[2], voffB[2];
#pragma unroll
    for (int i = 0; i < 2; ++i) { int R, C; stage_rc(tid * 16 + i * 8192, R, C); const int Rb = Epi::PERM ? ((R & ~31) + perm32(R & 31)) : R;
        voffA[i] = (unsigned)(R * K + C) * 2u; voffB[i] = (unsigned)(Rb * K + C) * 2u; }
    const size_t kstep = (size_t)(BK * 2);
    const size_t hstep = (size_t)HALF * K * 2;
    const size_t tstep = 2 * hstep;
    const unsigned ldsw = (unsigned)wid * 1024u;
    const int aoff = lds_byte(wr * 64 + fr, fq * 8), boff = lds_byte(wc * 32 + fr, fq * 8);
#define PG8_SA(b, h) (((b) * 2 + (h)) * HTB)
#define PG8_SB(b, h) ((4 + (b) * 2 + (h)) * HTB)
#define PG8_STAGE(bufoff, gbase, voff) do { _Pragma("unroll") for (int _i = 0; _i < 2; ++_i) \
        __builtin_amdgcn_global_load_lds((const unsigned*)((const char*)(gbase) + (voff)[_i]), (PG8_LAS unsigned*)(lds + (bufoff) + ldsw + _i * 8192), 16, 0, 0); } while (0)
#define PG8_LDA(dst, b, h) do { _Pragma("unroll") for (int m = 0; m < 4; ++m) _Pragma("unroll") for (int k = 0; k < 2; ++k) dst[m][k] = *(const PG8_LAS bf16x8*)(lds + PG8_SA(b, h) + aoff + m * 2048 + k * 1024); } while (0)
#define PG8_LDB(dst, b, h) do { _Pragma("unroll") for (int n = 0; n < 2; ++n) _Pragma("unroll") for (int k = 0; k < 2; ++k) dst[n][k] = *(const PG8_LAS bf16x8*)(lds + PG8_SB(b, h) + boff + n * 2048 + k * 1024); } while (0)
#define PG8_MMA(ai, bj, At, Bt) do { __builtin_amdgcn_s_setprio(1); _Pragma("unroll") for (int m = 0; m < 4; ++m) _Pragma("unroll") for (int n = 0; n < 2; ++n) _Pragma("unroll") for (int k = 0; k < 2; ++k) \
        acc[ai][bj][m][n] = __builtin_amdgcn_mfma_f32_16x16x32_bf16(Bt[n][k], At[m][k], acc[ai][bj][m][n], 0, 0, 0); __builtin_amdgcn_s_setprio(0); } while (0)
#define PG8_WAIT_V(n) asm volatile("s_waitcnt vmcnt(" #n ")" ::: "memory")
#define PG8_WAIT_L(n) asm volatile("s_waitcnt lgkmcnt(" #n ")" ::: "memory")
#define PG8_BAR __builtin_amdgcn_s_barrier()
#define PG8_SCHED __builtin_amdgcn_sched_barrier(0)
    Unit cur, nxt; int ui = 0;
    if (!S.next(0, cur)) return;
    f32x4 acc[2][2][4][2];
#pragma unroll
    for (int a = 0; a < 2; ++a)
#pragma unroll
        for (int b = 0; b < 2; ++b)
#pragma unroll
            for (int m = 0; m < 4; ++m)
#pragma unroll
                for (int n = 0; n < 2; ++n) acc[a][b][m][n] = (f32x4){0.f, 0.f, 0.f, 0.f};
    bf16x8 At[4][2], B0[2][2], B1[2][2];
    const char* cA = (const char*)g.A + (size_t)cur.pm * tstep; const char* cB = (const char*)g.Bt + (size_t)cur.pn * tstep;
    S.a_ready(cur);
    if constexpr (SP2) {
        PG8_STAGE(PG8_SB(0, 0), cB, voffB); PG8_STAGE(PG8_SB(0, 1), cB + hstep, voffB); PG8_STAGE(PG8_SA(0, 0), cA, voffA); PG8_STAGE(PG8_SA(0, 1), cA + hstep, voffA);
        if (wr == 1) PG8_BAR;
        PG8_WAIT_V(2); PG8_BAR;
        PG8_STAGE(PG8_SB(1, 0), cB + kstep, voffB); PG8_STAGE(PG8_SA(1, 0), cA + kstep, voffA); PG8_STAGE(PG8_SB(1, 1), cB + hstep + kstep, voffB);
        PG8_WAIT_V(6); PG8_BAR;
    } else {
        PG8_STAGE(PG8_SB(0, 0), cB, voffB); PG8_STAGE(PG8_SA(0, 0), cA, voffA); PG8_STAGE(PG8_SB(0, 1), cB + hstep, voffB); PG8_STAGE(PG8_SA(0, 1), cA + hstep, voffA);
        if (wr == 1) PG8_BAR;
        PG8_WAIT_V(4); PG8_BAR;
        PG8_STAGE(PG8_SB(1, 0), cB + kstep, voffB); PG8_STAGE(PG8_SA(1, 0), cA + kstep, voffA); PG8_STAGE(PG8_SB(1, 1), cB + hstep + kstep, voffB);
        PG8_WAIT_V(6); PG8_BAR;
    }
    for (;;) {
        const bool has_next = S.next(ui + 1, nxt);
        const char* nA = has_next ? (const char*)g.A + (size_t)nxt.pm * tstep : cA; const char* nB = has_next ? (const char*)g.Bt + (size_t)nxt.pn * tstep : cB;
        for (int t = 0; t < nt; t += 2) {
            const bool last = (t == nt - 2);
            const char* a1 = cA + (size_t)(t + 1) * kstep;
            const char* a2 = last ? nA : cA + (size_t)(t + 2) * kstep; const char* b2 = last ? nB : cB + (size_t)(t + 2) * kstep;
            const char* a3 = a2 + kstep; const char* b3 = b2 + kstep;
            if (last && has_next) S.a_ready(nxt);
            if constexpr (SP2) {
            PG8_LDB(B0, 0, 0); PG8_LDB(B1, 0, 1); PG8_SCHED; PG8_LDA(At, 0, 0); PG8_STAGE(PG8_SA(1, 1), a1 + hstep, voffA);
            PG8_WAIT_V(8); PG8_WAIT_L(0); PG8_BAR; PG8_MMA(0, 0, At, B0); PG8_MMA(0, 1, At, B1); PG8_BAR; PG8_SCHED;
            PG8_LDA(At, 0, 1); PG8_STAGE(PG8_SB(0, 0), b2, voffB); PG8_STAGE(PG8_SB(0, 1), b2 + hstep, voffB); PG8_STAGE(PG8_SA(0, 0), a2, voffA);
            PG8_WAIT_V(8); PG8_WAIT_L(0); PG8_BAR; PG8_MMA(1, 0, At, B0); PG8_MMA(1, 1, At, B1); PG8_BAR; PG8_SCHED;
            PG8_LDB(B0, 1, 0); PG8_LDB(B1, 1, 1); PG8_SCHED; PG8_LDA(At, 1, 0); PG8_STAGE(PG8_SA(0, 1), a2 + hstep, voffA);
            PG8_WAIT_V(8); PG8_WAIT_L(0); PG8_BAR; PG8_MMA(0, 0, At, B0); PG8_MMA(0, 1, At, B1); PG8_BAR; PG8_SCHED;
            PG8_LDA(At, 1, 1); PG8_STAGE(PG8_SB(1, 0), b3, voffB); PG8_STAGE(PG8_SB(1, 1), b3 + hstep, voffB); PG8_STAGE(PG8_SA(1, 0), a3, voffA);
            PG8_WAIT_V(8); PG8_WAIT_L(0); PG8_BAR; PG8_MMA(1, 0, At, B0); PG8_MMA(1, 1, At, B1); PG8_BAR; PG8_SCHED;
            } else {
            PG8_LDB(B0, 0, 0); PG8_SCHED; PG8_LDA(At, 0, 0); PG8_STAGE(PG8_SA(1, 1), a1 + hstep, voffA);
            PG8_WAIT_L(8); PG8_BAR; PG8_WAIT_L(0); PG8_MMA(0, 0, At, B0); PG8_BAR; PG8_SCHED;
            PG8_LDB(B1, 0, 1); PG8_STAGE(PG8_SB(0, 0), b2, voffB);
            PG8_BAR; PG8_WAIT_L(0); PG8_MMA(0, 1, At, B1); PG8_BAR;
            PG8_LDA(At, 0, 1); PG8_STAGE(PG8_SA(0, 0), a2, voffA);
            PG8_BAR; PG8_WAIT_L(0); PG8_MMA(1, 0, At, B0); PG8_BAR; PG8_SCHED;
            PG8_STAGE(PG8_SB(0, 1), b2 + hstep, voffB);
            PG8_WAIT_V(6); PG8_BAR; PG8_MMA(1, 1, At, B1); PG8_BAR;
            PG8_LDB(B0, 1, 0); PG8_SCHED; PG8_LDA(At, 1, 0); PG8_STAGE(PG8_SA(0, 1), a2 + hstep, voffA);
            PG8_WAIT_L(8); PG8_BAR; PG8_WAIT_L(0); PG8_MMA(0, 0, At, B0); PG8_BAR; PG8_SCHED;
            PG8_LDB(B1, 1, 1); PG8_STAGE(PG8_SB(1, 0), b3, voffB);
            PG8_BAR; PG8_WAIT_L(0); PG8_MMA(0, 1, At, B1); PG8_BAR;
            PG8_LDA(At, 1, 1); PG8_STAGE(PG8_SA(1, 0), a3, voffA);
            PG8_BAR; PG8_WAIT_L(0); PG8_MMA(1, 0, At, B0); PG8_BAR; PG8_SCHED;
            PG8_STAGE(PG8_SB(1, 1), b3 + hstep, voffB);
            PG8_WAIT_V(6); PG8_BAR; PG8_MMA(1, 1, At, B1); PG8_BAR;
            }
        }
        if constexpr (ALIGN_EPI) { if (wr == 0) PG8_BAR; }
        if constexpr (!Epi::AFTER_DRAIN) { E(acc, cur, wr, wc, fr, fq); S.done(cur); }
        if (!has_next) break;
#pragma unroll
        for (int a = 0; a < 2; ++a)
#pragma unroll
            for (int b = 0; b < 2; ++b)
#pragma unroll
                for (int m = 0; m < 4; ++m)
#pragma unroll
                    for (int n = 0; n < 2; ++n) acc[a][b][m][n] = (f32x4){0.f, 0.f, 0.f, 0.f};
        cur = nxt; cA = nA; cB = nB; ++ui;
        if constexpr (ALIGN_EPI) { if (wr == 1) PG8_BAR; }
    }
    PG8_WAIT_V(0);
    if constexpr (!ALIGN_EPI) { if (wr == 0) PG8_BAR; }
    PG8_BAR;
    if constexpr (Epi::AFTER_DRAIN) { E.fused(acc, cur, wr, wc, fr, fq, lds, wid, lane); S.done(cur); }
#undef PG8_SA
#undef PG8_SB
#undef PG8_STAGE
#undef PG8_LDA
#undef PG8_LDB
#undef PG8_MMA
#undef PG8_WAIT_V
#undef PG8_WAIT_L
#undef PG8_BAR
#undef PG8_SCHED
}
}

#define LAS __attribute__((address_space(3)))
using pg8::bf16_t; using pg8::bf16x8; using pg8::f32x4; using pg8::u32x4; using pg8::Unit; using pg8::cvt_pk_bf16;
typedef float f32x16 __attribute__((ext_vector_type(16)));
typedef unsigned u32x2 __attribute__((ext_vector_type(2)));
typedef short v4i16_t __attribute__((ext_vector_type(4)));

constexpr int MP = 32 * 2048, MS = 32 * 32, MT = MP + MS;
constexpr int DIN = 3080, NQKV = 3072, DFF = 2816, PLE = 256;
constexpr int TA_S = 544, TB_S = 4128;
constexpr float EPS = 1e-6f, LOG2E = 1.4426950408889634f, QSCALE = 0.125f * LOG2E, NEGB = -1e30f;
constexpr size_t O_Y = 0, O_KA_P = (size_t)MT * 1024, O_VA_P = O_KA_P + 32u * 512 * 512, O_KB_P = O_VA_P + 32u * 512 * 512, O_VB_P = O_KB_P + (size_t)MP * 512,
                 O_LF_P = O_VB_P + (size_t)MP * 512, O_KA_S = O_LF_P + (size_t)MP * 8, O_VA_S = O_KA_S + (size_t)MS * 512, O_KB_S = O_VA_S + (size_t)MS * 512,
                 O_VB_S = O_KB_S + (size_t)MS * 512, O_LF_S = O_VB_S + (size_t)MS * 512, O_END = O_LF_S + (size_t)MS * 8;
constexpr size_t MiB = 1u << 20;
constexpr size_t WS_WQKV = 1 * MiB, WS_WO = 7 * MiB, WS_WGU = 9 * MiB, WS_WD = 20 * MiB, WS_WPG = 26 * MiB, WS_WPP = 28 * MiB, WS_GAINS = 28 * MiB + 768 * 1024, WS_RSTD0 = 29 * MiB, WS_SSQ1 = 30 * MiB, WS_SSQ2 = 35 * MiB;
constexpr size_t WS_XB = 40 * MiB, WS_PB = 170 * MiB, WS_O = 203 * MiB, WS_QKVP = 333 * MiB, WS_H = 333 * MiB;
constexpr size_t WS_QAS = 717 * MiB, WS_QBS = 718 * MiB, WS_KAN = 719 * MiB, WS_VAN = 720 * MiB, WS_KBN = 721 * MiB, WS_VBN = 722 * MiB, WS_PP = 723 * MiB, WS_END = 853 * MiB;
constexpr size_t PSTRIDE = (size_t)32 * 8 * 2048 * 64;
constexpr int LDS_BYTES = 147456;

struct Args { const float* in[25]; float* out; unsigned char* ws; int ph_lo, ph_hi; };

__device__ __forceinline__ int lane_id_fresh() { int l; asm volatile("v_mbcnt_lo_u32_b32 %0, -1, 0\n\tv_mbcnt_hi_u32_b32 %0, -1, %0" : "=v"(l)); return l; }
__device__ __forceinline__ float wave_sum(float v) {
#pragma unroll
    for (int o = 1; o < 64; o <<= 1) v += __shfl_xor(v, o);
    return v;
}
__device__ __forceinline__ float bf_lo(unsigned u) { return __uint_as_float(u << 16); }
__device__ __forceinline__ float bf_hi(unsigned u) { return __uint_as_float(u & 0xffff0000u); }
__device__ __forceinline__ float fast_rcp(float x) { return __builtin_amdgcn_rcpf(x); }
__device__ __forceinline__ float fast_exp2(float x) { return __builtin_amdgcn_exp2f(x); }

struct EpiQKV {
    static constexpr bool PERM = true, AFTER_DRAIN = false;
    const float* rstd0; const float* gains; unsigned char* ws; float* out;
    __device__ __forceinline__ void operator()(const f32x4 (&acc)[2][2][4][2], const Unit& u, int wr, int wc, int fr, int fq) const {
        const int kind = u.pn >> 1, head = ((u.pn & 1) << 2) + wc, sub = kind % 3; const bool isB = kind >= 3;
        f32x4 gn[2][2];
        if (sub != 2) { const float* gp = gains + ((isB ? 2 : 0) + sub) * 64; const float sc = sub == 0 ? QSCALE : 1.0f;
#pragma unroll
            for (int bj = 0; bj < 2; ++bj)
#pragma unroll
                for (int n = 0; n < 2; ++n) gn[bj][n] = *(const f32x4*)(gp + 32 * bj + 8 * fq + 4 * n) * sc; }
        else { gn[0][0] = gn[0][1] = gn[1][0] = gn[1][1] = (f32x4){1.f, 1.f, 1.f, 1.f}; }
#pragma unroll
        for (int ai = 0; ai < 2; ++ai)
#pragma unroll
            for (int m = 0; m < 4; ++m) {
                const int rl = ai * 128 + wr * 64 + m * 16 + fr, row = u.pm * 256 + rl;
                const float rs = rstd0[row];
                f32x4 v[2][2];
#pragma unroll
                for (int bj = 0; bj < 2; ++bj)
#pragma unroll
                    for (int n = 0; n < 2; ++n) v[bj][n] = acc[ai][bj][m][n] * rs;
                if (sub != 2) {
                    float ss = 0.f;
#pragma unroll
                    for (int bj = 0; bj < 2; ++bj)
#pragma unroll
                        for (int n = 0; n < 2; ++n) { const f32x4 x = v[bj][n]; ss += (x[0] * x[0] + x[1] * x[1]) + (x[2] * x[2] + x[3] * x[3]); }
                    ss += __shfl_xor(ss, 16); ss += __shfl_xor(ss, 32);
                    const float hr = rsqrtf(ss * (1.0f / 64.0f) + EPS);
#pragma unroll
                    for (int bj = 0; bj < 2; ++bj)
#pragma unroll
                        for (int n = 0; n < 2; ++n) v[bj][n] = v[bj][n] * hr * gn[bj][n];
                }
                bf16_t* dst; float* fo = nullptr;
                if (u.pm < 256) {
                    const int b = u.pm >> 3, t = ((u.pm & 7) << 8) + rl;
                    dst = (bf16_t*)(ws + WS_QKVP) + (size_t)kind * PSTRIDE + ((size_t)(b * 8 + head) * 2048 + t) * 64;
                    if (sub != 0) {
                        if (isB) fo = out + (sub == 1 ? O_KB_P : O_VB_P) + ((size_t)(b * 2048 + t) * 8 + head) * 64;
                        else if (t >= 1536) fo = out + (sub == 1 ? O_KA_P : O_VA_P) + ((size_t)(b * 512 + (t - 1536)) * 8 + head) * 64;
                    }
                } else {
                    const int rp = (u.pm - 256) * 256 + rl, b = rp >> 5, t = rp & 31;
                    if (sub == 0) dst = (bf16_t*)(ws + (isB ? WS_QBS : WS_QAS)) + ((size_t)(b * 8 + head) * 32 + t) * 64;
                    else if (!isB) { dst = (bf16_t*)(ws + (sub == 1 ? WS_KAN : WS_VAN)) + ((size_t)(b * 8 + head) * 32 + t) * 64;
                                     fo = out + (sub == 1 ? O_KA_S : O_VA_S) + ((size_t)(b * 32 + t) * 8 + head) * 64; }
                    else { dst = (bf16_t*)(ws + (sub == 1 ? WS_KBN : WS_VBN)) + ((size_t)(b * 8 + head) * 32 + t) * 64;
                           fo = out + (sub == 1 ? O_KB_S : O_VB_S) + ((size_t)(b * 32 + t) * 8 + head) * 64; }
                }
#pragma unroll
                for (int bj = 0; bj < 2; ++bj) {
                    const int col = 32 * bj + 8 * fq; const f32x4 v0 = v[bj][0], v1 = v[bj][1];
                    u32x4 w; w.x = cvt_pk_bf16(v0[0], v0[1]); w.y = cvt_pk_bf16(v0[2], v0[3]); w.z = cvt_pk_bf16(v1[0], v1[1]); w.w = cvt_pk_bf16(v1[2], v1[3]);
                    *(u32x4*)(dst + col) = w;
                    if (fo) { *(f32x4*)(fo + col) = v0; *(f32x4*)(fo + col + 4) = v1; }
                }
            }
    }
};
struct EpiStore {
    static constexpr bool PERM = true, AFTER_DRAIN = false;
    bf16_t* O; int ldc;
    __device__ __forceinline__ void operator()(const f32x4 (&acc)[2][2][4][2], const Unit& u, int wr, int wc, int fr, int fq) const {
#pragma unroll
        for (int ai = 0; ai < 2; ++ai)
#pragma unroll
            for (int m = 0; m < 4; ++m) { const int row = u.pm * 256 + ai * 128 + wr * 64 + m * 16 + fr;
#pragma unroll
                for (int bj = 0; bj < 2; ++bj) { const int col = u.pn * 256 + 128 * bj + 32 * wc + 8 * fq; const f32x4 v0 = acc[ai][bj][m][0], v1 = acc[ai][bj][m][1];
                    u32x4 w; w.x = cvt_pk_bf16(v0[0], v0[1]); w.y = cvt_pk_bf16(v0[2], v0[3]); w.z = cvt_pk_bf16(v1[0], v1[1]); w.w = cvt_pk_bf16(v1[2], v1[3]);
                    *(u32x4*)(O + (size_t)row * ldc + col) = w; } }
    }
};
template <bool F32BASE> struct EpiRes {
    static constexpr bool PERM = true, AFTER_DRAIN = false;
    const float* base_p; const float* base_s; bf16_t* xb; float* ssq;
    __device__ __forceinline__ void operator()(const f32x4 (&acc)[2][2][4][2], const Unit& u, int wr, int wc, int fr, int fq) const {
#pragma unroll
        for (int ai = 0; ai < 2; ++ai)
#pragma unroll
            for (int m = 0; m < 4; ++m) { const int row = u.pm * 256 + ai * 128 + wr * 64 + m * 16 + fr;
                const float* bp = (u.pm < 256) ? base_p + (size_t)row * 1024 : base_s + (size_t)(row - MP) * 1024;
                float s = 0.f;
#pragma unroll
                for (int bj = 0; bj < 2; ++bj) { const int col = u.pn * 256 + 128 * bj + 32 * wc + 8 * fq;
                    f32x4 r0, r1;
                    if (F32BASE) { r0 = *(const f32x4*)(bp + col); r1 = *(const f32x4*)(bp + col + 4); }
                    else { const u32x4 rw = *(const u32x4*)(xb + (size_t)row * 1024 + col); r0 = (f32x4){bf_lo(rw.x), bf_hi(rw.x), bf_lo(rw.y), bf_hi(rw.y)}; r1 = (f32x4){bf_lo(rw.z), bf_hi(rw.z), bf_lo(rw.w), bf_hi(rw.w)}; }
                    const f32x4 v0 = acc[ai][bj][m][0] + r0, v1 = acc[ai][bj][m][1] + r1;
                    u32x4 w; w.x = cvt_pk_bf16(v0[0], v0[1]); w.y = cvt_pk_bf16(v0[2], v0[3]); w.z = cvt_pk_bf16(v1[0], v1[1]); w.w = cvt_pk_bf16(v1[2], v1[3]);
                    *(u32x4*)(xb + (size_t)row * 1024 + col) = w;
                    s += (v0[0] * v0[0] + v0[1] * v0[1]) + (v0[2] * v0[2] + v0[3] * v0[3]) + (v1[0] * v1[0] + v1[1] * v1[1]) + (v1[2] * v1[2] + v1[3] * v1[3]); }
                s += __shfl_xor(s, 16); s += __shfl_xor(s, 32);
                if (fq == 0) ssq[(size_t)row * 16 + u.pn * 4 + wc] = s; }
    }
};
__device__ __forceinline__ float row_rstd(const float* ssq, int row) {
    const f32x4 a = *(const f32x4*)(ssq + (size_t)row * 16), b = *(const f32x4*)(ssq + (size_t)row * 16 + 4), c = *(const f32x4*)(ssq + (size_t)row * 16 + 8), d = *(const f32x4*)(ssq + (size_t)row * 16 + 12);
    const float t = ((a[0] + a[1]) + (a[2] + a[3])) + ((b[0] + b[1]) + (b[2] + b[3])) + ((c[0] + c[1]) + (c[2] + c[3])) + ((d[0] + d[1]) + (d[2] + d[3]));
    return rsqrtf(t * (1.0f / 1024.0f) + EPS);
}
struct EpiSwiGLU {
    static constexpr bool PERM = true, AFTER_DRAIN = false;
    const float* ssq; bf16_t* H;
    __device__ __forceinline__ void operator()(const f32x4 (&acc)[2][2][4][2], const Unit& u, int wr, int wc, int fr, int fq) const {
#pragma unroll
        for (int ai = 0; ai < 2; ++ai)
#pragma unroll
            for (int m = 0; m < 4; ++m) { const int row = u.pm * 256 + ai * 128 + wr * 64 + m * 16 + fr; const float rs = row_rstd(ssq, row);
                float hv[8];
#pragma unroll
                for (int n = 0; n < 2; ++n)
#pragma unroll
                    for (int e = 0; e < 4; ++e) { const float g = acc[ai][0][m][n][e] * rs, up = acc[ai][1][m][n][e] * rs;
                        hv[4 * n + e] = g * up * fast_rcp(1.0f + fast_exp2(-g * LOG2E)); }
                u32x4 w; w.x = cvt_pk_bf16(hv[0], hv[1]); w.y = cvt_pk_bf16(hv[2], hv[3]); w.z = cvt_pk_bf16(hv[4], hv[5]); w.w = cvt_pk_bf16(hv[6], hv[7]);
                *(u32x4*)(H + (size_t)row * DFF + u.pn * 128 + 32 * wc + 8 * fq) = w; }
    }
};
struct EpiPle {
    static constexpr bool PERM = true, AFTER_DRAIN = false;
    const float* ssq; const bf16_t* PP; const bf16_t* xb; float* y;
    __device__ __forceinline__ void operator()(const f32x4 (&acc)[2][2][4][2], const Unit& u, int wr, int wc, int fr, int fq) const {
#pragma unroll
        for (int ai = 0; ai < 2; ++ai)
#pragma unroll
            for (int m = 0; m < 4; ++m) { const int row = u.pm * 256 + ai * 128 + wr * 64 + m * 16 + fr; const float rs = row_rstd(ssq, row);
#pragma unroll
                for (int bj = 0; bj < 2; ++bj) { const int col = u.pn * 256 + 128 * bj + 32 * wc + 8 * fq; float* yp = y + (size_t)row * 1024 + col;
                    const u32x4 pw = *(const u32x4*)(PP + (size_t)row * 1024 + col);
                    const u32x4 xw = *(const u32x4*)(xb + (size_t)row * 1024 + col);
                    const f32x4 x0 = (f32x4){bf_lo(xw.x), bf_hi(xw.x), bf_lo(xw.y), bf_hi(xw.y)}, x1 = (f32x4){bf_lo(xw.z), bf_hi(xw.z), bf_lo(xw.w), bf_hi(xw.w)};
                    const f32x4 a0 = acc[ai][bj][m][0] * rs, a1 = acc[ai][bj][m][1] * rs;
                    f32x4 o0, o1;
                    o0[0] = x0[0] + bf_lo(pw.x) * fast_rcp(1.0f + fast_exp2(-a0[0] * LOG2E)); o0[1] = x0[1] + bf_hi(pw.x) * fast_rcp(1.0f + fast_exp2(-a0[1] * LOG2E));
                    o0[2] = x0[2] + bf_lo(pw.y) * fast_rcp(1.0f + fast_exp2(-a0[2] * LOG2E)); o0[3] = x0[3] + bf_hi(pw.y) * fast_rcp(1.0f + fast_exp2(-a0[3] * LOG2E));
                    o1[0] = x1[0] + bf_lo(pw.z) * fast_rcp(1.0f + fast_exp2(-a1[0] * LOG2E)); o1[1] = x1[1] + bf_hi(pw.z) * fast_rcp(1.0f + fast_exp2(-a1[1] * LOG2E));
                    o1[2] = x1[2] + bf_lo(pw.w) * fast_rcp(1.0f + fast_exp2(-a1[2] * LOG2E)); o1[3] = x1[3] + bf_hi(pw.w) * fast_rcp(1.0f + fast_exp2(-a1[3] * LOG2E));
                    *(f32x4*)yp = o0; *(f32x4*)(yp + 4) = o1; } }
    }
};

__device__ __forceinline__ void tr_item(const float* W, int ldw, int K, int srccol0, bf16_t* WT, int dstrow0, const float* gain, LAS float* scr, int kb, int lane) {
    const int k0 = 64 * kb;
#pragma unroll 8
    for (int i = 0; i < 32; ++i) { const int kk = 2 * i + (lane >> 5); float v = W[(size_t)(k0 + kk) * ldw + srccol0 + (lane & 31)]; if (gain) v *= gain[k0 + kk]; scr[kk * 33 + (lane & 31)] = v; }
    asm volatile("s_waitcnt lgkmcnt(0)" ::: "memory");
    const int c = lane & 7;
#pragma unroll
    for (int j = 0; j < 4; ++j) { const int n = (lane >> 3) + 8 * j; const LAS float* s = scr + (8 * c) * 33 + n;
        u32x4 o; o.x = cvt_pk_bf16(s[0 * 33], s[1 * 33]); o.y = cvt_pk_bf16(s[2 * 33], s[3 * 33]); o.z = cvt_pk_bf16(s[4 * 33], s[5 * 33]); o.w = cvt_pk_bf16(s[6 * 33], s[7 * 33]);
        *(u32x4*)(WT + (size_t)(dstrow0 + n) * K + k0 + 8 * c) = o; }
    asm volatile("s_waitcnt lgkmcnt(0)" ::: "memory");
}
__device__ __forceinline__ void cvt8(const float* src, bf16_t* dst) {
    const f32x4 a = *(const f32x4*)src, b = *(const f32x4*)(src + 4);
    u32x4 w; w.x = cvt_pk_bf16(a[0], a[1]); w.y = cvt_pk_bf16(a[2], a[3]); w.z = cvt_pk_bf16(b[0], b[1]); w.w = cvt_pk_bf16(b[2], b[3]);
    *(u32x4*)dst = w;
}
__device__ __forceinline__ void tr_set(const Args& a, LAS unsigned char* lds, int wave, int lane, const int set, int gw, int NGW) {
    unsigned char* ws = a.ws;
    LAS float* scr = (LAS float*)(lds + wave * 16384);
    constexpr int I_QKV = 16 * 96, I_O = 16 * 32, I_GU = 16 * 176, I_D = 44 * 32, I_PG = 16 * 32, I_PP = 4 * 32;
    const int ntot = set == 0 ? I_QKV : (set == 1 ? I_O + I_GU : I_D + I_PG + I_PP);
    for (int it = gw; it < ntot; it += NGW) {
        int r = it;
        if (set == 0) { const int kb = r / 96, nb = r % 96, pn = nb >> 3, bj = (nb >> 2) & 1, wc = nb & 3;
            tr_item(a.in[10], DIN, 1024, 256 * pn + 64 * wc + 32 * bj, (bf16_t*)(ws + WS_WQKV), 32 * nb, a.in[9], scr, kb, lane); continue; }
        if (set == 1) {
            if (r < I_O) { const int kb = r / 32, nb = r % 32; tr_item(a.in[17], 1024, 1024, 32 * nb, (bf16_t*)(ws + WS_WO), 32 * nb, nullptr, scr, kb, lane); continue; } r -= I_O;
            { const int kb = r / 176, nb = r % 176, pn = nb >> 3, bj = (nb >> 2) & 1, q = nb & 3;
              tr_item(bj ? a.in[20] : a.in[19], DFF, 1024, 128 * pn + 32 * q, (bf16_t*)(ws + WS_WGU), 32 * nb, a.in[18], scr, kb, lane); continue; }
        }
        if (r < I_D) { const int kb = r / 32, nb = r % 32; tr_item(a.in[21], 1024, DFF, 32 * nb, (bf16_t*)(ws + WS_WD), 32 * nb, nullptr, scr, kb, lane); continue; } r -= I_D;
        if (r < I_PG) { const int kb = r / 32, nb = r % 32; tr_item(a.in[23], 1024, 1024, 32 * nb, (bf16_t*)(ws + WS_WPG), 32 * nb, a.in[22], scr, kb, lane); continue; } r -= I_PG;
        { const int kb = r / 32, nb = r % 32; tr_item(a.in[24], 1024, PLE, 32 * nb, (bf16_t*)(ws + WS_WPP), 32 * nb, nullptr, scr, kb, lane); }
    }
}
__device__ __forceinline__ void shadow_share(int nu, int G, int c, int& rank, int& count) {
    const int tailc = nu - (nu / G) * G; const bool split = tailc > 0 && tailc * 2 < G;
    if (!split) { rank = c; count = G; } else if (c >= tailc) { rank = c - tailc; count = G - tailc; } else { rank = 0; count = 0; }
}
__device__ __forceinline__ void p_convert(const Args& a, const size_t gt, const size_t NT) {
    unsigned char* ws = a.ws;
    for (size_t i0 = gt; i0 < (size_t)MT * 32; i0 += 4 * NT) {
        f32x4 r[4][2];
#pragma unroll
        for (int q = 0; q < 4; ++q) { const size_t i = i0 + q * NT; if (i < (size_t)MT * 32) { const size_t row = i >> 5; const int c8 = (int)(i & 31);
            const float* src = row < (size_t)MP ? a.in[7] + row * 256 + c8 * 8 : a.in[8] + (row - MP) * 256 + c8 * 8; r[q][0] = *(const f32x4*)src; r[q][1] = *(const f32x4*)(src + 4); } }
#pragma unroll
        for (int q = 0; q < 4; ++q) { const size_t i = i0 + q * NT; if (i < (size_t)MT * 32) {
            u32x4 w; w.x = cvt_pk_bf16(r[q][0][0], r[q][0][1]); w.y = cvt_pk_bf16(r[q][0][2], r[q][0][3]); w.z = cvt_pk_bf16(r[q][1][0], r[q][1][1]); w.w = cvt_pk_bf16(r[q][1][2], r[q][1][3]);
            *(u32x4*)((bf16_t*)(ws + WS_PB) + i * 8) = w; } }
    }
}
__device__ __forceinline__ void phase0(const Args& a, LAS unsigned char* lds, int wave) {
    const int lane = lane_id_fresh(), tid = wave * 64 + lane;
    unsigned char* ws = a.ws;
    const int gw = blockIdx.x * 8 + wave, NGW = gridDim.x * 8;
    tr_set(a, lds, wave, lane, 0, gw, NGW);
    if (blockIdx.x == 0 && tid < 256) { const int w = tid >> 6, d = tid & 63; ((float*)(ws + WS_GAINS))[tid] = a.in[12 + w][d]; }
    if (blockIdx.x == 0 && wave == 0) {
        float ga = fabsf(a.in[12][lane]), ka = fabsf(a.in[13][lane]), gb = fabsf(a.in[14][lane]), kb = fabsf(a.in[15][lane]);
#pragma unroll
        for (int o = 1; o < 64; o <<= 1) { ga = fmaxf(ga, __shfl_xor(ga, o)); ka = fmaxf(ka, __shfl_xor(ka, o)); gb = fmaxf(gb, __shfl_xor(gb, o)); kb = fmaxf(kb, __shfl_xor(kb, o)); }
        if (lane == 0) { ((float*)(ws + WS_GAINS))[256] = 64.0f * QSCALE * ga * ka + 1.0f; ((float*)(ws + WS_GAINS))[257] = 64.0f * QSCALE * gb * kb + 1.0f; }
    }
    if (blockIdx.x == 0) {
        const float* tb = a.in[16] + wave * 257;
        float mx = fmaxf(fmaxf(tb[lane], tb[lane + 64]), fmaxf(tb[lane + 128], tb[lane + 192])); mx = fmaxf(mx, tb[256]);
#pragma unroll
        for (int o = 1; o < 64; o <<= 1) mx = fmaxf(mx, __shfl_xor(mx, o));
        if (lane == 0) ((float*)(ws + WS_GAINS))[264 + wave] = mx;
    }
    __syncthreads();
    {
        LAS float* wf = (LAS float*)lds;
        for (int i = tid; i < 8192; i += 512) { const int j = i >> 10, k = i & 1023; wf[i] = a.in[9][k] * a.in[10][(size_t)k * DIN + 3072 + j]; }
        __syncthreads();
        f32x4 wr[8][4];
#pragma unroll
        for (int jj = 0; jj < 8; ++jj)
#pragma unroll
            for (int j = 0; j < 4; ++j) wr[jj][j] = *(const LAS f32x4*)(wf + jj * 1024 + (lane + 64 * j) * 4);
        for (int row0 = gw; row0 < MT; row0 += 2 * NGW) {
            f32x4 vv[2][4];
#pragma unroll
            for (int rr = 0; rr < 2; ++rr) { const int row = row0 + rr * NGW < MT ? row0 + rr * NGW : row0;
                const float* xr = row < MP ? a.in[0] + (size_t)row * 1024 : a.in[1] + (size_t)(row - MP) * 1024;
#pragma unroll
                for (int j = 0; j < 4; ++j) vv[rr][j] = ((const f32x4*)xr)[lane + 64 * j]; }
#pragma unroll
            for (int rr = 0; rr < 2; ++rr) {
                const int row = row0 + rr * NGW;
                if (row >= MT) break;
                f32x4 v[4];
#pragma unroll
                for (int j = 0; j < 4; ++j) v[j] = vv[rr][j];
                float ss = 0.f;
#pragma unroll
                for (int j = 0; j < 4; ++j) ss += (v[j][0] * v[j][0] + v[j][1] * v[j][1]) + (v[j][2] * v[j][2] + v[j][3] * v[j][3]);
                u32x2* xo = (u32x2*)((bf16_t*)(ws + WS_XB) + (size_t)row * 1024);
#pragma unroll
                for (int j = 0; j < 4; ++j) { u32x2 w; w.x = cvt_pk_bf16(v[j][0], v[j][1]); w.y = cvt_pk_bf16(v[j][2], v[j][3]); xo[lane + 64 * j] = w; }
                float d[8];
#pragma unroll
                for (int jj = 0; jj < 8; ++jj) { float t = 0.f;
#pragma unroll
                    for (int j = 0; j < 4; ++j) { const f32x4 w = wr[jj][j]; t += (v[j][0] * w[0] + v[j][1] * w[1]) + (v[j][2] * w[2] + v[j][3] * w[3]); }
                    d[jj] = t; }
                const bool b5 = (lane & 32) != 0, b4 = (lane & 16) != 0, b3 = (lane & 8) != 0;
                float e4[4], e2[2];
#pragma unroll
                for (int j = 0; j < 4; ++j) { const float snd = b5 ? d[j] : d[j + 4], kp = b5 ? d[j + 4] : d[j]; e4[j] = kp + __shfl_xor(snd, 32); }
#pragma unroll
                for (int j = 0; j < 2; ++j) { const float snd = b4 ? e4[j] : e4[j + 2], kp = b4 ? e4[j + 2] : e4[j]; e2[j] = kp + __shfl_xor(snd, 16); }
                float g; { const float snd = b3 ? e2[0] : e2[1], kp = b3 ? e2[1] : e2[0]; g = kp + __shfl_xor(snd, 8); }
                g += __shfl_xor(g, 4); g += __shfl_xor(g, 2); g += __shfl_xor(g, 1);
                const float rstd = rsqrtf(wave_sum(ss) * (1.0f / 1024.0f) + EPS);
                if ((lane & 7) == 0) { const int k = lane >> 3; g = g * rstd + a.in[11][k]; const float lf = fminf(g, 0.f) - log1pf(expf(-fabsf(g)));
                    float* dst = row < MP ? a.out + O_LF_P + (size_t)row * 8 : a.out + O_LF_S + (size_t)(row - MP) * 8; dst[k] = lf; }
                if (lane == 0) ((float*)(ws + WS_RSTD0))[row] = rstd;
            }
        }
    }
}

__device__ __forceinline__ int crow(int r, int hi) { return (r & 3) + 8 * (r >> 2) + 4 * hi; }
__device__ __forceinline__ void split3(float t, unsigned& h, unsigned& m, unsigned& l) {
    h = cvt_pk_bf16(t, 0.f) & 0xffffu; const float r1 = t - __uint_as_float(h << 16);
    m = cvt_pk_bf16(r1, 0.f) & 0xffffu; const float r2 = r1 - __uint_as_float(m << 16);
    l = cvt_pk_bf16(r2, 0.f) & 0xffffu;
}
__device__ __forceinline__ float qk_bound(const unsigned char* ws, const bool modeB, int lane) {
    (void)lane; return *(volatile const float*)((const float*)(ws + WS_GAINS) + 256 + (modeB ? 1 : 0));
}
__device__ __forceinline__ bf16x8 pack8(float a0, float a1, float a2, float a3, float a4, float a5, float a6, float a7) {
    u32x4 w; w.x = cvt_pk_bf16(a0, a1); w.y = cvt_pk_bf16(a2, a3); w.z = cvt_pk_bf16(a4, a5); w.w = cvt_pk_bf16(a6, a7); return __builtin_bit_cast(bf16x8, w);
}
constexpr int A_KS = 0, A_VS = 36864, A_TAB = 73728, A_TSP = 81920, A_WSF = 98304, A_SCAN = 100352, KVT = 128 * 72;
__device__ __forceinline__ void attn_tile(const LAS bf16_t* Kt, const LAS bf16_t* Vt, const bf16x8 (&qr)[4], const LAS float* tab, LAS float* wsf, const bool modeB, const int kb0, const int qw,
                                          const int lane, f32x16& o0, f32x16& o1, float& mrun, float& lrun, const bf16x8 bq = (bf16x8){0, 0, 0, 0, 0, 0, 0, 0}, const LAS u32x2* tsp = nullptr) {
    const int r32 = lane & 31, hi = lane >> 5, qa = qw + r32;
    bf16x8 kf0[4], kf1[4];
#pragma unroll
    for (int d0 = 0; d0 < 4; ++d0) { kf0[d0] = *(const LAS bf16x8*)(Kt + r32 * 72 + d0 * 16 + hi * 8); kf1[d0] = *(const LAS bf16x8*)(Kt + (32 + r32) * 72 + d0 * 16 + hi * 8); }
    const LAS bf16_t* vb = Vt + (4 * hi + ((lane & 15) >> 2)) * 72 + 16 * ((lane >> 4) & 1) + 4 * (lane & 3);
    v4i16_t vlo[8], vup[8];
#pragma unroll
    for (int g = 0; g < 4; ++g)
#pragma unroll
        for (int d0 = 0; d0 < 2; ++d0) {
            vlo[2 * g + d0] = __builtin_amdgcn_ds_read_tr16_b64_v4i16((LAS v4i16_t*)(vb + (16 * g) * 72 + 32 * d0));
            vup[2 * g + d0] = __builtin_amdgcn_ds_read_tr16_b64_v4i16((LAS v4i16_t*)(vb + (16 * g + 8) * 72 + 32 * d0)); }
    f32x16 p0, p1;
    bf16x8 ab0, ab1;
    if (modeB) {
        const u32x2 t0 = tsp[kb0 + r32], t1 = tsp[kb0 + 32 + r32];
        ab0 = __builtin_bit_cast(bf16x8, (u32x4){t0.x, t0.y, 0x3F803F80u, 0u}); ab1 = __builtin_bit_cast(bf16x8, (u32x4){t1.x, t1.y, 0x3F803F80u, 0u});
#pragma unroll
        for (int r = 0; r < 16; ++r) { p0[r] = 0.f; p1[r] = 0.f; }
    } else {
        if (qw - (kb0 + 63) >= 128) { const float c = tab[256];
#pragma unroll
            for (int r = 0; r < 16; ++r) { p0[r] = c; p1[r] = c; } }
        else {
#pragma unroll
            for (int r = 0; r < 16; ++r) { const int rel = qa - (kb0 + crow(r, hi)); int i0 = rel < -128 ? -128 : rel; i0 = i0 > 128 ? 128 : i0; int i1 = rel - 32 < -128 ? -128 : rel - 32; i1 = i1 > 128 ? 128 : i1;
                p0[r] = tab[i0 + 128]; p1[r] = tab[i1 + 128]; } }
    }
    if (modeB) { p0 = __builtin_amdgcn_mfma_f32_32x32x16_bf16(ab0, bq, p0, 0, 0, 0); p1 = __builtin_amdgcn_mfma_f32_32x32x16_bf16(ab1, bq, p1, 0, 0, 0); }
#pragma unroll
    for (int d0 = 0; d0 < 4; ++d0) {
        p0 = __builtin_amdgcn_mfma_f32_32x32x16_bf16(kf0[d0], qr[d0], p0, 0, 0, 0);
        p1 = __builtin_amdgcn_mfma_f32_32x32x16_bf16(kf1[d0], qr[d0], p1, 0, 0, 0);
    }
    if (modeB && kb0 + 63 > qw) {
#pragma unroll
        for (int r = 0; r < 16; ++r) { const int kk = kb0 + crow(r, hi); if (kk > qa) p0[r] = NEGB; if (kk + 32 > qa) p1[r] = NEGB; } }
    float sum = 0.f;
#pragma unroll
    for (int r = 0; r < 16; ++r) { p0[r] = fast_exp2(p0[r]); p1[r] = fast_exp2(p1[r]); sum += p0[r] + p1[r]; }
    lrun += sum;
    bf16x8 pa[4];
    pa[0] = pack8(p0[0], p0[1], p0[2], p0[3], p0[4], p0[5], p0[6], p0[7]); pa[1] = pack8(p0[8], p0[9], p0[10], p0[11], p0[12], p0[13], p0[14], p0[15]);
    pa[2] = pack8(p1[0], p1[1], p1[2], p1[3], p1[4], p1[5], p1[6], p1[7]); pa[3] = pack8(p1[8], p1[9], p1[10], p1[11], p1[12], p1[13], p1[14], p1[15]);
#pragma unroll
    for (int g = 0; g < 4; ++g) {
#pragma unroll
        for (int d0 = 0; d0 < 2; ++d0) {
            const v4i16_t lo = vlo[2 * g + d0], up = vup[2 * g + d0];
            const bf16x8 vf = (bf16x8){lo[0], lo[1], lo[2], lo[3], up[0], up[1], up[2], up[3]};
            if (d0 == 0) o0 = __builtin_amdgcn_mfma_f32_32x32x16_bf16(pa[g], vf, o0, 0, 0, 0);
            else         o1 = __builtin_amdgcn_mfma_f32_32x32x16_bf16(pa[g], vf, o1, 0, 0, 0);
        }
    }
}
__device__ __forceinline__ void attn_bias_init(f32x16& p0, f32x16& p1, const LAS float* tab, const bool modeB, const int kb0, const int qw, const int qa, const int hi) {
    if (modeB) {
#pragma unroll
        for (int rg = 0; rg < 4; ++rg) { const f32x4 c0 = *(const LAS f32x4*)(tab + kb0 + 8 * rg + 4 * hi), c1 = *(const LAS f32x4*)(tab + kb0 + 32 + 8 * rg + 4 * hi);
#pragma unroll
            for (int i = 0; i < 4; ++i) { p0[4 * rg + i] = c0[i]; p1[4 * rg + i] = c1[i]; } }
    } else if (qw - (kb0 + 63) >= 128) { const float c = tab[256];
#pragma unroll
        for (int r = 0; r < 16; ++r) { p0[r] = c; p1[r] = c; }
    } else {
#pragma unroll
        for (int r = 0; r < 16; ++r) { const int rel = qa - (kb0 + crow(r, hi)); int i0 = rel < -128 ? -128 : rel; i0 = i0 > 128 ? 128 : i0; int i1 = rel - 32 < -128 ? -128 : rel - 32; i1 = i1 > 128 ? 128 : i1;
            p0[r] = tab[i0 + 128]; p1[r] = tab[i1 + 128]; }
    }
}
__device__ __forceinline__ void attn_softmax_pv(f32x16& p0, f32x16& p1, const LAS bf16_t* Vt, LAS float* wsf, const int lane, f32x16& o0, f32x16& o1, float& mrun, float& lrun) {
    const int r32 = lane & 31, hi = lane >> 5;
    float mx = fmaxf(p0[0], p1[0]);
#pragma unroll
    for (int r = 1; r < 16; ++r) mx = fmaxf(mx, fmaxf(p0[r], p1[r]));
    mx = fmaxf(mx, __shfl_xor(mx, 32));
    const float mnew = fmaxf(mrun, mx), alpha = fast_exp2(mrun - mnew); mrun = mnew;
    wsf[r32] = alpha;
    float sum = 0.f;
#pragma unroll
    for (int r = 0; r < 16; ++r) { p0[r] = fast_exp2(p0[r] - mnew); p1[r] = fast_exp2(p1[r] - mnew); sum += p0[r] + p1[r]; }
    lrun = lrun * alpha + sum;
#pragma unroll
    for (int rg = 0; rg < 4; ++rg) { const f32x4 f = *(const LAS f32x4*)(wsf + 8 * rg + 4 * hi);
#pragma unroll
        for (int i = 0; i < 4; ++i) { o0[4 * rg + i] *= f[i]; o1[4 * rg + i] *= f[i]; } }
    bf16x8 pa[4];
    pa[0] = pack8(p0[0], p0[1], p0[2], p0[3], p0[4], p0[5], p0[6], p0[7]); pa[1] = pack8(p0[8], p0[9], p0[10], p0[11], p0[12], p0[13], p0[14], p0[15]);
    pa[2] = pack8(p1[0], p1[1], p1[2], p1[3], p1[4], p1[5], p1[6], p1[7]); pa[3] = pack8(p1[8], p1[9], p1[10], p1[11], p1[12], p1[13], p1[14], p1[15]);
    const LAS bf16_t* vb = Vt + (4 * hi + ((lane & 15) >> 2)) * 72 + 16 * ((lane >> 4) & 1) + 4 * (lane & 3);
#pragma unroll
    for (int g = 0; g < 4; ++g) {
#pragma unroll
        for (int d0 = 0; d0 < 2; ++d0) {
            const v4i16_t lo = __builtin_amdgcn_ds_read_tr16_b64_v4i16((LAS v4i16_t*)(vb + (16 * g) * 72 + 32 * d0));
            const v4i16_t up = __builtin_amdgcn_ds_read_tr16_b64_v4i16((LAS v4i16_t*)(vb + (16 * g + 8) * 72 + 32 * d0));
            const bf16x8 vf = (bf16x8){lo[0], lo[1], lo[2], lo[3], up[0], up[1], up[2], up[3]};
            if (d0 == 0) o0 = __builtin_amdgcn_mfma_f32_32x32x16_bf16(pa[g], vf, o0, 0, 0, 0);
            else         o1 = __builtin_amdgcn_mfma_f32_32x32x16_bf16(pa[g], vf, o1, 0, 0, 0);
        }
    }
}
__device__ __forceinline__ void attn_pair(const LAS bf16_t* Kt, const LAS bf16_t* Vt, const bf16x8 (&qr)[4], const LAS float* tab, LAS float* wsf, const bool modeB, const int kb0, const int qw,
                                          const int lane, f32x16& o0, f32x16& o1, float& mrun, float& lrun) {
    const int r32 = lane & 31, hi = lane >> 5, qa = qw + r32;
    f32x16 a0, a1, b0, b1;
    attn_bias_init(a0, a1, tab, modeB, kb0, qw, qa, hi); attn_bias_init(b0, b1, tab, modeB, kb0 + 64, qw, qa, hi);
#pragma unroll
    for (int d0 = 0; d0 < 4; ++d0) {
        const LAS bf16_t* kp = Kt + r32 * 72 + d0 * 16 + hi * 8;
        const bf16x8 k0 = *(const LAS bf16x8*)(kp), k1 = *(const LAS bf16x8*)(kp + 32 * 72), k2 = *(const LAS bf16x8*)(kp + 64 * 72), k3 = *(const LAS bf16x8*)(kp + 96 * 72);
        a0 = __builtin_amdgcn_mfma_f32_32x32x16_bf16(k0, qr[d0], a0, 0, 0, 0); a1 = __builtin_amdgcn_mfma_f32_32x32x16_bf16(k1, qr[d0], a1, 0, 0, 0);
        b0 = __builtin_amdgcn_mfma_f32_32x32x16_bf16(k2, qr[d0], b0, 0, 0, 0); b1 = __builtin_amdgcn_mfma_f32_32x32x16_bf16(k3, qr[d0], b1, 0, 0, 0);
    }
    attn_softmax_pv(a0, a1, Vt, wsf, lane, o0, o1, mrun, lrun);
    attn_softmax_pv(b0, b1, Vt + 64 * 72, wsf, lane, o0, o1, mrun, lrun);
}
__device__ __forceinline__ void attn_unit(const Args& a, LAS unsigned char* lds, const bool modeB, int bh, int wave) {
    const int lane = lane_id_fresh(), tid = wave * 64 + lane;
    unsigned char* ws = a.ws;
    const int b = bh >> 3, h = bh & 7, r32 = lane & 31, hi = lane >> 5;
    const size_t hb = (size_t)(b * 8 + h) * 2048 * 64; const bf16_t* base = (const bf16_t*)(ws + WS_QKVP) + (modeB ? 3 : 0) * PSTRIDE;
    const bf16_t* Q = base + hb; const bf16_t* K = base + PSTRIDE + hb; const bf16_t* V = base + 2 * PSTRIDE + hb;
    const size_t orow0 = (size_t)b * 2048;
    const int colbase = (modeB ? 512 : 0) + h * 64;
    LAS bf16_t* Ks = (LAS bf16_t*)(lds + A_KS); LAS bf16_t* Vs = (LAS bf16_t*)(lds + A_VS);
    LAS float* tab = (LAS float*)(lds + A_TAB); LAS float* wsf = (LAS float*)(lds + A_WSF) + wave * 64; LAS float* scanw = (LAS float*)(lds + A_SCAN); LAS u32x2* tsp = (LAS u32x2*)(lds + A_TSP);
    __syncthreads();
    if (modeB) {
        const int k0 = tid * 4;
        const float* lf0 = a.out + O_LF_P + (size_t)b * 2048 * 8 + h;
        float v0 = lf0[(size_t)k0 * 8], v1 = lf0[(size_t)(k0 + 1) * 8], v2 = lf0[(size_t)(k0 + 2) * 8], v3 = lf0[(size_t)(k0 + 3) * 8];
        const float loc = (v0 + v1) + (v2 + v3);
        float inc = loc;
#pragma unroll
        for (int o = 1; o < 64; o <<= 1) { const float y = __int_as_float(__builtin_amdgcn_ds_bpermute(((lane - o) & 63) << 2, __float_as_int(inc))); if (lane >= o) inc += y; }
        if (lane == 63) scanw[wave] = inc;
        __syncthreads();
        float run = inc - loc;
        for (int w = 0; w < wave; ++w) run += scanw[w];
        float tv[4]; run += v0; tv[0] = -run * LOG2E; run += v1; tv[1] = -run * LOG2E; run += v2; tv[2] = -run * LOG2E; run += v3; tv[3] = -run * LOG2E;
#pragma unroll
        for (int i = 0; i < 4; ++i) { tab[k0 + i] = tv[i]; unsigned hh, mm, ll; split3(tv[i], hh, mm, ll); tsp[k0 + i] = (u32x2){hh | (mm << 16), ll | 0x3F800000u}; }
    } else {
        for (int i = tid; i < 257; i += 512) tab[i] = a.in[16][h * 257 + i] * LOG2E;
    }
    __syncthreads();
    const float bqk = qk_bound(ws, modeB, lane);
    const int srow = tid >> 3, sch = tid & 7;
    for (int qb = 0; qb < 8; ++qb) {
        const int q0 = qb * 256, qw = q0 + 32 * wave;
        int tlo, thi, blo, bhi;
        if (modeB) { tlo = 0; thi = (qw + 31) >> 6; blo = 0; bhi = (q0 + 255) >> 6; }
        else { const int c = qw >> 6; tlo = c > 8 ? c - 8 : 0; thi = c; const int c0 = q0 >> 6; blo = c0 > 8 ? c0 - 8 : 0; bhi = (q0 + 224) >> 6; }
        const int Tlo = blo >> 1, Thi = bhi >> 1;
        bf16x8 qr[4];
#pragma unroll
        for (int d0 = 0; d0 < 4; ++d0) qr[d0] = *(const bf16x8*)(Q + (size_t)(qw + r32) * 64 + d0 * 16 + hi * 8);
        float mrun = (modeB ? tab[qw + r32] : 0.f) + bqk, lrun = 0.f; f32x16 o0 = {}, o1 = {};
        bf16x8 bq;
        { unsigned hh, mm, ll; split3(-mrun, hh, mm, ll);
          const u32x4 w = hi == 0 ? (u32x4){0x3F803F80u, 0x3F80u | (hh << 16), mm | (ll << 16), 0u} : (u32x4){0u, 0u, 0u, 0u}; bq = __builtin_bit_cast(bf16x8, w); }
        u32x4 kr0, kr1, vr0, vr1;
        { const size_t ro = (size_t)(128 * Tlo + srow) * 64 + sch * 8;
          kr0 = *(const u32x4*)(K + ro); kr1 = *(const u32x4*)(K + ro + 64 * 64); vr0 = *(const u32x4*)(V + ro); vr1 = *(const u32x4*)(V + ro + 64 * 64); }
        *(LAS u32x4*)(Ks + srow * 72 + sch * 8) = kr0; *(LAS u32x4*)(Ks + (64 + srow) * 72 + sch * 8) = kr1;
        *(LAS u32x4*)(Vs + srow * 72 + sch * 8) = vr0; *(LAS u32x4*)(Vs + (64 + srow) * 72 + sch * 8) = vr1;
        __syncthreads();
        for (int T = Tlo; T <= Thi; ++T) {
            const int cur = (T - Tlo) & 1;
            if (T < Thi) { const size_t ro = (size_t)(128 * (T + 1) + srow) * 64 + sch * 8;
                kr0 = *(const u32x4*)(K + ro); kr1 = *(const u32x4*)(K + ro + 64 * 64); vr0 = *(const u32x4*)(V + ro); vr1 = *(const u32x4*)(V + ro + 64 * 64); }
            const LAS bf16_t* Kt = Ks + cur * KVT; const LAS bf16_t* Vt = Vs + cur * KVT;
            if (2 * T >= tlo && 2 * T <= thi) attn_tile(Kt, Vt, qr, tab, wsf, modeB, 128 * T, qw, lane, o0, o1, mrun, lrun, bq, tsp);
            if (2 * T + 1 >= tlo && 2 * T + 1 <= thi) attn_tile(Kt + 64 * 72, Vt + 64 * 72, qr, tab, wsf, modeB, 128 * T + 64, qw, lane, o0, o1, mrun, lrun, bq, tsp);
            if (T < Thi) { LAS bf16_t* Kn = Ks + (cur ^ 1) * KVT; LAS bf16_t* Vn = Vs + (cur ^ 1) * KVT;
                *(LAS u32x4*)(Kn + srow * 72 + sch * 8) = kr0; *(LAS u32x4*)(Kn + (64 + srow) * 72 + sch * 8) = kr1;
                *(LAS u32x4*)(Vn + srow * 72 + sch * 8) = vr0; *(LAS u32x4*)(Vn + (64 + srow) * 72 + sch * 8) = vr1; }
            __syncthreads();
        }
        {
            float lt; { const auto rr_ = __builtin_amdgcn_permlane32_swap(__float_as_uint(lrun), __float_as_uint(lrun), false, false); lt = __uint_as_float(rr_[0]) + __uint_as_float(rr_[1]); }
            if (hi == 0) wsf[r32] = fast_rcp(lt);
            asm volatile("s_waitcnt lgkmcnt(0)" ::: "memory");
            LAS bf16_t* stg = (LAS bf16_t*)(lds + A_SCAN + 512) + wave * 2048;
#pragma unroll
            for (int r = 0; r < 16; ++r) { const int rr = crow(r, hi); const float f = wsf[rr];
                stg[rr * 64 + r32] = (bf16_t)(cvt_pk_bf16(o0[r] * f, 0.f) & 0xffffu); stg[rr * 64 + 32 + r32] = (bf16_t)(cvt_pk_bf16(o1[r] * f, 0.f) & 0xffffu); }
            asm volatile("s_waitcnt lgkmcnt(0)" ::: "memory");
            bf16_t* Ow = (bf16_t*)(ws + WS_O) + (orow0 + qw) * 1024 + colbase;
#pragma unroll
            for (int i = 0; i < 4; ++i) { const int row = i * 8 + (lane >> 3), ch = lane & 7; *(u32x4*)(Ow + (size_t)row * 1024 + ch * 8) = *(const LAS u32x4*)(stg + row * 64 + ch * 8); }
        }
    }
}

constexpr int A2_KV = 0, A2_TAB = 73728, A2_WSF = 76032;
__device__ __forceinline__ void attn_unit_A2(const Args& a, LAS unsigned char* lds, int u, int wave) {
    const int lane = lane_id_fresh(), tid = wave * 64 + lane;
    unsigned char* ws = a.ws;
    const int part = u & 1, bhp = u >> 1, b = bhp >> 2, g = wave >> 2, h = 2 * (bhp & 3) + g, wg = wave & 3, r32 = lane & 31, hi = lane >> 5;
    const size_t hb = (size_t)(b * 8 + h) * 2048 * 64; const bf16_t* base = (const bf16_t*)(ws + WS_QKVP);
    const bf16_t* Q = base + hb; const bf16_t* K = base + PSTRIDE + hb; const bf16_t* V = base + 2 * PSTRIDE + hb;
    const size_t orow0 = (size_t)b * 2048; const int colbase = h * 64;
    LAS bf16_t* Kg = (LAS bf16_t*)(lds + A2_KV + g * 36864); LAS bf16_t* Vg = Kg + 2 * 4608;
    LAS float* tab = (LAS float*)(lds + A2_TAB) + g * 288; LAS float* wsf = (LAS float*)(lds + A2_WSF) + wave * 64;
    __syncthreads();
    {
        const int gt = tid & 255;
        const float off = qk_bound(ws, false, lane) + *(volatile const float*)((const float*)(ws + WS_GAINS) + 264 + h) * LOG2E;
        tab[gt] = a.in[16][h * 257 + gt] * LOG2E - off; if (gt == 0) tab[256] = a.in[16][h * 257 + 256] * LOG2E - off;
    }
    __syncthreads();
    const int gt = tid & 255, srow = gt >> 2, sc = (gt & 3) * 16;
    for (int qb = part; qb < 16; qb += 2) {
        const int q0 = qb * 128, qw = q0 + 32 * wg, c = qw >> 6;
        const int tlo = c > 8 ? c - 8 : 0, thi = c, blo = 2 * qb > 8 ? 2 * qb - 8 : 0, bhi = 2 * qb + 1;
        bf16x8 qr[4];
#pragma unroll
        for (int d0 = 0; d0 < 4; ++d0) qr[d0] = *(const bf16x8*)(Q + (size_t)(qw + r32) * 64 + d0 * 16 + hi * 8);
        float mrun = 0.f, lrun = 0.f; f32x16 o0 = {}, o1 = {};
        u32x4 kr0, kr1, vr0, vr1;
        { const size_t ro = (size_t)(64 * blo + srow) * 64 + sc;
          kr0 = *(const u32x4*)(K + ro); kr1 = *(const u32x4*)(K + ro + 8); vr0 = *(const u32x4*)(V + ro); vr1 = *(const u32x4*)(V + ro + 8); }
        *(LAS u32x4*)(Kg + srow * 72 + sc) = kr0; *(LAS u32x4*)(Kg + srow * 72 + sc + 8) = kr1;
        *(LAS u32x4*)(Vg + srow * 72 + sc) = vr0; *(LAS u32x4*)(Vg + srow * 72 + sc + 8) = vr1;
        __syncthreads();
        for (int t = blo; t <= bhi; ++t) {
            const int cur = (t - blo) & 1;
            if (t < bhi) { const size_t ro = (size_t)(64 * (t + 1) + srow) * 64 + sc;
                kr0 = *(const u32x4*)(K + ro); kr1 = *(const u32x4*)(K + ro + 8); vr0 = *(const u32x4*)(V + ro); vr1 = *(const u32x4*)(V + ro + 8); }
            if (t >= tlo && t <= thi) attn_tile(Kg + cur * 4608, Vg + cur * 4608, qr, tab, wsf, false, 64 * t, qw, lane, o0, o1, mrun, lrun);
            if (t < bhi) { LAS bf16_t* Kn = Kg + (cur ^ 1) * 4608; LAS bf16_t* Vn = Vg + (cur ^ 1) * 4608;
                *(LAS u32x4*)(Kn + srow * 72 + sc) = kr0; *(LAS u32x4*)(Kn + srow * 72 + sc + 8) = kr1;
                *(LAS u32x4*)(Vn + srow * 72 + sc) = vr0; *(LAS u32x4*)(Vn + srow * 72 + sc + 8) = vr1; }
            __syncthreads();
        }
        {
            float lt; { const auto rr_ = __builtin_amdgcn_permlane32_swap(__float_as_uint(lrun), __float_as_uint(lrun), false, false); lt = __uint_as_float(rr_[0]) + __uint_as_float(rr_[1]); }
            if (hi == 0) wsf[r32] = fast_rcp(lt);
            asm volatile("s_waitcnt lgkmcnt(0)" ::: "memory");
            LAS bf16_t* stg = (LAS bf16_t*)(lds + A2_WSF + 2304) + wave * 2048;
#pragma unroll
            for (int r = 0; r < 16; ++r) { const int rr = crow(r, hi); const float f = wsf[rr];
                stg[rr * 64 + r32] = (bf16_t)(cvt_pk_bf16(o0[r] * f, 0.f) & 0xffffu); stg[rr * 64 + 32 + r32] = (bf16_t)(cvt_pk_bf16(o1[r] * f, 0.f) & 0xffffu); }
            asm volatile("s_waitcnt lgkmcnt(0)" ::: "memory");
            bf16_t* Ow = (bf16_t*)(ws + WS_O) + (orow0 + qw) * 1024 + colbase;
#pragma unroll
            for (int i = 0; i < 4; ++i) { const int row = i * 8 + (lane >> 3), ch = lane & 7; *(u32x4*)(Ow + (size_t)row * 1024 + ch * 8) = *(const LAS u32x4*)(stg + row * 64 + ch * 8); }
        }
    }
}

constexpr int S_KV = 0, S_TAB = 73728, S_WSF = 90368, S_SCAN = 92416;
__device__ __forceinline__ void samp_tile(const LAS bf16_t* Kw, const bf16x8 (&qr)[4], const LAS bf16_t* Vw, const LAS float* tab, LAS float* wsf, const bool modeB, const bool isnew, const int t0,
                                          const int lane, f32x16& o0, f32x16& o1, float& mrun, float& lrun) {
    const int r32 = lane & 31, hi = lane >> 5;
    f32x16 p = {};
#pragma unroll
    for (int d0 = 0; d0 < 4; ++d0) { const bf16x8 kf = *(const LAS bf16x8*)(Kw + r32 * 72 + d0 * 16 + hi * 8); p = __builtin_amdgcn_mfma_f32_32x32x16_bf16(kf, qr[d0], p, 0, 0, 0); }
    if (modeB) {
#pragma unroll
        for (int rg = 0; rg < 4; ++rg) { const f32x4 c0 = *(const LAS f32x4*)(tab + t0 + 8 * rg + 4 * hi);
#pragma unroll
            for (int i = 0; i < 4; ++i) p[4 * rg + i] += c0[i]; }
        if (isnew) {
#pragma unroll
            for (int r = 0; r < 16; ++r) if (crow(r, hi) > r32) p[r] = NEGB; }
    } else {
        if (512 - (t0 + 31) >= 128) { const float c = tab[256];
#pragma unroll
            for (int r = 0; r < 16; ++r) p[r] += c; }
        else {
#pragma unroll
            for (int r = 0; r < 16; ++r) { const int rel = 512 + r32 - (t0 + crow(r, hi)); int i0 = rel < -128 ? -128 : rel; i0 = i0 > 128 ? 128 : i0; p[r] += tab[i0 + 128]; } }
    }
    float sum = 0.f;
#pragma unroll
    for (int r = 0; r < 16; ++r) { p[r] = fast_exp2(p[r] - mrun); sum += p[r]; }
    lrun += sum;
    bf16x8 pa[2];
    pa[0] = pack8(p[0], p[1], p[2], p[3], p[4], p[5], p[6], p[7]); pa[1] = pack8(p[8], p[9], p[10], p[11], p[12], p[13], p[14], p[15]);
    const LAS bf16_t* vb = Vw + (4 * hi + ((lane & 15) >> 2)) * 72 + 16 * ((lane >> 4) & 1) + 4 * (lane & 3);
#pragma unroll
    for (int g = 0; g < 2; ++g) {
#pragma unroll
        for (int d0 = 0; d0 < 2; ++d0) {
            const v4i16_t lo = __builtin_amdgcn_ds_read_tr16_b64_v4i16((LAS v4i16_t*)(vb + (16 * g) * 72 + 32 * d0));
            const v4i16_t up = __builtin_amdgcn_ds_read_tr16_b64_v4i16((LAS v4i16_t*)(vb + (16 * g + 8) * 72 + 32 * d0));
            const bf16x8 vf = (bf16x8){lo[0], lo[1], lo[2], lo[3], up[0], up[1], up[2], up[3]};
            if (d0 == 0) o0 = __builtin_amdgcn_mfma_f32_32x32x16_bf16(pa[g], vf, o0, 0, 0, 0);
            else         o1 = __builtin_amdgcn_mfma_f32_32x32x16_bf16(pa[g], vf, o1, 0, 0, 0);
        }
    }
}
__device__ __forceinline__ void samp_unit(const Args& a, LAS unsigned char* lds, const bool modeB, int bh, int wave) {
    const int lane = lane_id_fresh(), tid = wave * 64 + lane;
    unsigned char* ws = a.ws;
    const int b = bh >> 3, h = bh & 7, r32 = lane & 31, hi = lane >> 5;
    const int P = modeB ? 4096 : 512, ttot = P + 32;
    const float* Kc = a.in[modeB ? 4 : 2] + (size_t)b * P * 512 + h * 64;
    const float* Vc = a.in[modeB ? 5 : 3] + (size_t)b * P * 512 + h * 64;
    const bf16_t* Qn = (const bf16_t*)(ws + (modeB ? WS_QBS : WS_QAS)) + (size_t)(b * 8 + h) * 2048;
    const bf16_t* Kn = (const bf16_t*)(ws + (modeB ? WS_KBN : WS_KAN)) + (size_t)(b * 8 + h) * 2048;
    const bf16_t* Vn = (const bf16_t*)(ws + (modeB ? WS_VBN : WS_VAN)) + (size_t)(b * 8 + h) * 2048;
    LAS bf16_t* Kw = (LAS bf16_t*)(lds + S_KV) + wave * 4608; LAS bf16_t* Vw = Kw + 2304;
    LAS float* tab = (LAS float*)(lds + S_TAB); LAS float* wsf = (LAS float*)(lds + S_WSF) + wave * 64; LAS float* scanw = (LAS float*)(lds + S_SCAN);
    __syncthreads();
    if (modeB) {
        const int per = (ttot + 511) >> 9, k0 = tid * per;
        const float* lf0 = a.in[6] + (size_t)b * 4096 * 8 + h; const float* lf1 = a.out + O_LF_S + (size_t)b * 32 * 8 + h;
        float loc = 0.f;
        for (int i = 0; i < per; ++i) { const int k = k0 + i; if (k < ttot) loc += (k < P) ? lf0[(size_t)k * 8] : lf1[(size_t)(k - P) * 8]; }
        float inc = loc;
#pragma unroll
        for (int o = 1; o < 64; o <<= 1) { const float y = __int_as_float(__builtin_amdgcn_ds_bpermute(((lane - o) & 63) << 2, __float_as_int(inc))); if (lane >= o) inc += y; }
        if (lane == 63) scanw[wave] = inc;
        __syncthreads();
        float run = inc - loc;
        for (int w = 0; w < wave; ++w) run += scanw[w];
        for (int i = 0; i < per; ++i) { const int k = k0 + i; if (k < ttot) { run += (k < P) ? lf0[(size_t)k * 8] : lf1[(size_t)(k - P) * 8]; tab[k] = -run * LOG2E; } }
    } else {
        const float off = qk_bound(ws, false, lane) + *(volatile const float*)((const float*)(ws + WS_GAINS) + 264 + h) * LOG2E;
        for (int i = tid; i < 257; i += 512) tab[i] = a.in[16][h * 257 + i] * LOG2E - off;
    }
    __syncthreads();
    bf16x8 qr[4];
#pragma unroll
    for (int d0 = 0; d0 < 4; ++d0) qr[d0] = *(const bf16x8*)(Qn + r32 * 64 + d0 * 16 + hi * 8);
    float mrun = modeB ? tab[P + r32] + qk_bound(ws, true, lane) : 0.f, lrun = 0.f; f32x16 o0 = {}, o1 = {};
    const int ntile = P >> 5;
    f32x4 rk[8], rv[8];
    const size_t lo_off = (size_t)(lane >> 4) * 512 + 4 * (lane & 15);
    const int lw = (lane >> 4) * 72 + 4 * (lane & 15);
    int t = wave;
    {
#pragma unroll
        for (int j = 0; j < 8; ++j) { rk[j] = __builtin_nontemporal_load((const f32x4*)(Kc + (size_t)t * 16384 + lo_off + (size_t)j * 2048)); rv[j] = __builtin_nontemporal_load((const f32x4*)(Vc + (size_t)t * 16384 + lo_off + (size_t)j * 2048)); }
    }
    for (; t < ntile; t += 8) {
#pragma unroll
        for (int j = 0; j < 8; ++j) { u32x2 wk, wv; wk.x = cvt_pk_bf16(rk[j][0], rk[j][1]); wk.y = cvt_pk_bf16(rk[j][2], rk[j][3]); wv.x = cvt_pk_bf16(rv[j][0], rv[j][1]); wv.y = cvt_pk_bf16(rv[j][2], rv[j][3]);
            *(LAS u32x2*)(Kw + lw + j * 288) = wk; *(LAS u32x2*)(Vw + lw + j * 288) = wv; }
        if (t + 8 < ntile) {
#pragma unroll
            for (int j = 0; j < 8; ++j) { rk[j] = __builtin_nontemporal_load((const f32x4*)(Kc + (size_t)(t + 8) * 16384 + lo_off + (size_t)j * 2048)); rv[j] = __builtin_nontemporal_load((const f32x4*)(Vc + (size_t)(t + 8) * 16384 + lo_off + (size_t)j * 2048)); }
        }
        samp_tile(Kw, qr, Vw, tab, wsf, modeB, false, 32 * t, lane, o0, o1, mrun, lrun);
    }
    if (wave == 0) {
#pragma unroll
        for (int j = 0; j < 4; ++j) { const int row = (lane >> 3) + 8 * j, col = 8 * (lane & 7);
            *(LAS bf16x8*)(Kw + row * 72 + col) = *(const bf16x8*)(Kn + row * 64 + col); *(LAS bf16x8*)(Vw + row * 72 + col) = *(const bf16x8*)(Vn + row * 64 + col); }
        samp_tile(Kw, qr, Vw, tab, wsf, modeB, true, P, lane, o0, o1, mrun, lrun);
    }
    {
        float lt; { const auto rr_ = __builtin_amdgcn_permlane32_swap(__float_as_uint(lrun), __float_as_uint(lrun), false, false); lt = __uint_as_float(rr_[0]) + __uint_as_float(rr_[1]); }
        LAS float* oc = (LAS float*)(lds + S_KV + wave * 9216); LAS float* ml = oc + 2048;
#pragma unroll
        for (int r = 0; r < 16; ++r) { oc[crow(r, hi) * 64 + r32] = o0[r]; oc[crow(r, hi) * 64 + 32 + r32] = o1[r]; }
        if (hi == 0) { ml[2 * r32] = mrun; ml[2 * r32 + 1] = lt; }
    }
    __syncthreads();
    {
        const int q = tid >> 4, d4 = (tid & 15) * 4;
        const LAS float* mlb = (const LAS float*)(lds + S_KV) + 2048 + 2 * q; const LAS float* ocb = (const LAS float*)(lds + S_KV) + q * 64 + d4;
        float M = mlb[0];
#pragma unroll
        for (int w = 1; w < 8; ++w) M = fmaxf(M, mlb[w * 2304]);
        f32x4 num = {0.f, 0.f, 0.f, 0.f}; float den = 0.f;
#pragma unroll
        for (int w = 0; w < 8; ++w) { const float f = fast_exp2(mlb[w * 2304] - M); den += f * mlb[w * 2304 + 1]; num += *(const LAS f32x4*)(ocb + w * 2304) * f; }
        const float inv = 1.0f / den;
        u32x2 w2; w2.x = cvt_pk_bf16(num[0] * inv, num[1] * inv); w2.y = cvt_pk_bf16(num[2] * inv, num[3] * inv);
        *(u32x2*)((bf16_t*)(ws + WS_O) + ((size_t)MP + b * 32 + q) * 1024 + (modeB ? 512 : 0) + h * 64 + d4) = w2;
    }
}

#define XB_TMO      128
#define XB_XCNT(j)  (256  + 64 * (j))
#define XB_XSUB(j)  (1280 + 64 * (j))
#define XB_XGEN(j)  (2304 + 64 * (j))
#define XB_TOP      3328
#define XB_TOPGEN   3392
#define XB_SPIN_CAP (1u << 20)
__device__ __forceinline__ unsigned xb_ld(unsigned* p)              { return __hip_atomic_load(p, __ATOMIC_RELAXED, __HIP_MEMORY_SCOPE_AGENT); }
__device__ __forceinline__ unsigned xb_add(unsigned* p, unsigned v) { return __hip_atomic_fetch_add(p, v, __ATOMIC_RELAXED, __HIP_MEMORY_SCOPE_AGENT); }
__device__ __forceinline__ unsigned xb_xcc_id() { return (unsigned)__builtin_amdgcn_s_getreg((3 << 11) | 20) & 0xFu; }
#define XB_SPIN(cond, bar) do { unsigned _sp = 0; while (cond) { __builtin_amdgcn_s_sleep(1); \
    if ((++_sp & 255u) == 0u) { if (xb_ld(&(bar)[XB_TMO])) break; if (_sp > XB_SPIN_CAP) { atomicAdd(&(bar)[XB_TMO], 1u); break; } } } } while (0)
__device__ __forceinline__ void xcd_barrier_complete(unsigned* bar, unsigned x, unsigned G, unsigned& nloc, unsigned& nx) {
    unsigned sum, cnt, mine, sp = 0u;
    for (;;) {
        sum = 0u; cnt = 0u; mine = 0u;
#pragma unroll
        for (unsigned j = 0; j < 16; ++j) { const unsigned c = xb_ld(&bar[XB_XCNT(j)]); sum += c; cnt += (c > 0u) ? 1u : 0u; mine = (j == x) ? c : mine; }
        if (sum == G) break;
        __builtin_amdgcn_s_sleep(1);
        if ((++sp & 255u) == 0u) { if (xb_ld(&bar[XB_TMO])) break; if (sp > XB_SPIN_CAP) { atomicAdd(&bar[XB_TMO], 1u); break; } }
    }
    nloc = mine > 0u ? mine : 1u; nx = cnt > 0u ? cnt : 1u;
}
__device__ __forceinline__ void grid_bar(unsigned* bar, volatile LAS unsigned* st, unsigned x, unsigned G, int wave) {
    asm volatile("s_waitcnt vmcnt(0)" ::: "memory");
    __syncthreads();
    if (wave == 0 && lane_id_fresh() == 0) {
        __builtin_amdgcn_s_waitcnt(0);
        unsigned nloc = st[0], nx = st[1];
        if (nloc == 0u) { xcd_barrier_complete(bar, x, G, nloc, nx); st[0] = nloc; st[1] = nx; }
        const unsigned old = xb_add(&bar[XB_XSUB(x)], 1u);
        const unsigned gen = old / nloc;
        if (old + 1u == (gen + 1u) * nloc) {
            __builtin_amdgcn_fence(__ATOMIC_RELEASE, "agent");
            asm volatile("s_waitcnt vmcnt(0)" ::: "memory");
            const unsigned og = xb_add(&bar[XB_TOP], 1u);
            const unsigned tg = og / nx;
            if (og + 1u == (tg + 1u) * nx) xb_add(&bar[XB_TOPGEN], 1u);
            else XB_SPIN(xb_ld(&bar[XB_TOPGEN]) == tg, bar);
            __builtin_amdgcn_fence(__ATOMIC_ACQUIRE, "agent");
            xb_add(&bar[XB_XGEN(x)], 1u);
            asm volatile("s_waitcnt vmcnt(0)" ::: "memory");
        } else {
            XB_SPIN(xb_ld(&bar[XB_XGEN(x)]) == gen, bar);
            __builtin_amdgcn_fence(__ATOMIC_ACQUIRE, "agent");
            asm volatile("s_waitcnt vmcnt(0)" ::: "memory");
        }
    }
    __syncthreads();
}

__global__ void __launch_bounds__(512, 2) mk_fwd(Args a) {
    extern __shared__ __attribute__((aligned(16))) unsigned char lds_raw[];
    LAS unsigned char* lds = (LAS unsigned char*)lds_raw;
    const int wave = __builtin_amdgcn_readfirstlane((int)threadIdx.x >> 6);
    unsigned char* ws = a.ws;
    const int lo = a.ph_lo, hi = a.ph_hi, G = gridDim.x, c = blockIdx.x;
#if MK_N_LAUNCHES == 1
    if (lo < 0) cg::this_grid().sync();
    volatile LAS unsigned* xb_st = (volatile LAS unsigned*)(lds + (LDS_BYTES - 16));
    const unsigned xb_x = xb_xcc_id();
    if (wave == 0 && lane_id_fresh() == 0) { xb_st[0] = 0u; xb_st[1] = 0u; (void)xb_add(&((unsigned*)ws)[XB_XCNT(xb_x)], 1u); }
    __syncthreads();
#define SEAM(k) do { if (lo <= (k) && (k) + 1 < hi) grid_bar((unsigned*)ws, xb_st, xb_x, (unsigned)G, wave); } while (0)
#else
#define SEAM(k) do { } while (0)
#endif
#define IN(k) (lo <= (k) && (k) < hi)
    if (IN(0)) { phase0(a, lds, wave); SEAM(0); }
    if (IN(1)) {
        pg8::Gemm g{(const bf16_t*)(ws + WS_XB), (const bf16_t*)(ws + WS_WQKV), MT, NQKV, 1024}; pg8::StaticOrder S; S.init(MT, NQKV, G, c);
        EpiQKV E{(const float*)(ws + WS_RSTD0), (const float*)(ws + WS_GAINS), ws, a.out};
        pg8::gemm_phase<EpiQKV, pg8::StaticOrder, true, true>(lds, g, S, E, wave);
        { int rk_, cn_; shadow_share((MT / 256) * (NQKV / 256), G, c, rk_, cn_); if (cn_ > 0) tr_set(a, lds, wave, lane_id_fresh(), 1, rk_ * 8 + wave, cn_ * 8); }
        SEAM(1);
    }
    if (IN(2)) {
        for (int i = 0; i < 4; ++i) { const int ty = (c & 1) ? ((i + 2) & 3) : i;
            for (int bh0 = c; bh0 < 256; bh0 += G) { int bh = bh0; asm volatile("" : "+s"(bh));
                if (ty == 0) { int one = 1; asm volatile("" : "+s"(one)); attn_unit(a, lds, one != 0, bh, wave); } else if (ty == 1) attn_unit_A2(a, lds, bh, wave); else samp_unit(a, lds, ty == 2, bh, wave); } }
        SEAM(2);
    }
    if (IN(3)) {
        { pg8::Gemm g{(const bf16_t*)(ws + WS_O), (const bf16_t*)(ws + WS_WO), MT, 1024, 1024}; pg8::StaticOrder S; S.init(MT, 1024, G, c);
          EpiRes<false> E{nullptr, nullptr, (bf16_t*)(ws + WS_XB), (float*)(ws + WS_SSQ1)};
          pg8::gemm_phase<EpiRes<false>, pg8::StaticOrder, true, true>(lds, g, S, E, wave); }
        { int rk_, cn_; shadow_share((MT / 256) * 4, G, c, rk_, cn_); if (cn_ > 0) p_convert(a, (size_t)rk_ * 512 + wave * 64 + lane_id_fresh(), (size_t)cn_ * 512); }
        SEAM(3);
    }
    if (IN(4)) {
        pg8::Gemm g{(const bf16_t*)(ws + WS_XB), (const bf16_t*)(ws + WS_WGU), MT, 2 * DFF, 1024}; pg8::StaticOrder S; S.init(MT, 2 * DFF, G, c);
        EpiSwiGLU E{(const float*)(ws + WS_SSQ1), (bf16_t*)(ws + WS_H)};
        pg8::gemm_phase<EpiSwiGLU, pg8::StaticOrder, true, true>(lds, g, S, E, wave);
        { int rk_, cn_; shadow_share((MT / 256) * (2 * DFF / 256), G, c, rk_, cn_); if (cn_ > 0) tr_set(a, lds, wave, lane_id_fresh(), 2, rk_ * 8 + wave, cn_ * 8); }
        SEAM(4);
    }
    if (IN(5)) {
        pg8::Gemm g{(const bf16_t*)(ws + WS_H), (const bf16_t*)(ws + WS_WD), MT, 1024, DFF}; pg8::StaticOrder S; S.init(MT, 1024, G, c);
        EpiRes<false> E{nullptr, nullptr, (bf16_t*)(ws + WS_XB), (float*)(ws + WS_SSQ2)};
        pg8::gemm_phase<EpiRes<false>, pg8::StaticOrder, true, true>(lds, g, S, E, wave);
        {
            const int nu = (MT / 256) * 4, tailc = nu - (nu / G) * G;
            const bool split = tailc > 0 && tailc * 2 < G;
            if (!split || c >= tailc) {
                pg8::Gemm g2{(const bf16_t*)(ws + WS_PB), (const bf16_t*)(ws + WS_WPP), MT, 1024, PLE}; pg8::StaticOrder S2; S2.init(MT, 1024, split ? G - tailc : G, split ? c - tailc : c);
                EpiStore E2{(bf16_t*)(ws + WS_PP), 1024};
                pg8::gemm_phase<EpiStore, pg8::StaticOrder, true, true>(lds, g2, S2, E2, wave);
            }
        }
        SEAM(5);
    }
    if (IN(6)) {
        pg8::Gemm g{(const bf16_t*)(ws + WS_XB), (const bf16_t*)(ws + WS_WPG), MT, 1024, 1024}; pg8::StaticOrder S; S.init(MT, 1024, G, c);
        EpiPle E{(const float*)(ws + WS_SSQ2), (const bf16_t*)(ws + WS_PP), (const bf16_t*)(ws + WS_XB), a.out + O_Y};
        pg8::gemm_phase<EpiPle, pg8::StaticOrder, true, true>(lds, g, S, E, wave);
    }
#undef IN
#undef SEAM
}

extern "C" void kernel_launch(void* const* d_in, const int* in_sizes, int n_in, void* d_out, int out_size, void* d_ws, size_t ws_size, hipStream_t stream) {
    static int grid = 0;
    if (grid == 0) {
        if (n_in != 25 || (size_t)out_size != O_END || ws_size < WS_END) { fprintf(stderr, "kernel_launch: unexpected shapes: n_in %d out %d (want %zu) ws %zu (want >= %zu)\n", n_in, out_size, (size_t)O_END, ws_size, (size_t)WS_END); if (n_in != 25 || ws_size < WS_END) { grid = -1; return; } }
        int dev = 0, cus = 0, per_cu = 0;
        if (hipGetDevice(&dev) != hipSuccess || hipDeviceGetAttribute(&cus, hipDeviceAttributeMultiprocessorCount, dev) != hipSuccess) { grid = -1; return; }
        if (hipFuncSetAttribute((const void*)mk_fwd, hipFuncAttributeMaxDynamicSharedMemorySize, LDS_BYTES) != hipSuccess) { fprintf(stderr, "kernel_launch: hipFuncSetAttribute failed\n"); grid = -1; return; }
        if (hipOccupancyMaxActiveBlocksPerMultiprocessor(&per_cu, (const void*)mk_fwd, 512, LDS_BYTES) != hipSuccess || per_cu < 1) { fprintf(stderr, "kernel_launch: occupancy query says %d\n", per_cu); per_cu = 1; }
        (void)hipGetLastError();
        grid = cus * per_cu;
    }
    if (grid < 0) return;
    Args a{};
    for (int i = 0; i < 25; ++i) a.in[i] = (const float*)d_in[i];
    a.out = (float*)d_out; a.ws = (unsigned char*)d_ws;
#if MK_N_LAUNCHES == 1
    a.ph_lo = 0; a.ph_hi = 7;
    if (hipMemsetAsync(d_ws, 0, 16384, stream) != hipSuccess) { fprintf(stderr, "kernel_launch: memset failed\n"); return; }
    void* args[] = {&a};
    hipError_t e = hipLaunchCooperativeKernel((const void*)mk_fwd, dim3(grid), dim3(512), args, LDS_BYTES, stream);
    if (e != hipSuccess) fprintf(stderr, "kernel_launch: cooperative launch failed: %s (grid %d)\n", hipGetErrorString(e), grid);
#else
    for (int ph = 0; ph < 7; ++ph) { a.ph_lo = ph; a.ph_hi = ph + 1; hipLaunchKernelGGL(mk_fwd, dim3(grid), dim3(512), LDS_BYTES, stream, a); }
#endif
}
```

```cpp
#include <hip/hip_runtime.h>
#include <hip/hip_cooperative_groups.h>
#include <cstdio>
#include <cstdint>
namespace cg = cooperative_groups;
#ifndef MK_N_LAUNCHES
#define MK_N_LAUNCHES 1
#endif
namespace pg8 {
#define PG8_LAS __attribute__((address_space(3)))
typedef unsigned short bf16_t;
typedef short bf16x8 __attribute__((ext_vector_type(8)));
typedef float f32x4 __attribute__((ext_vector_type(4)));
typedef unsigned u32x4 __attribute__((ext_vector_type(4)));
constexpr int BM = 256, BK = 64, HALF = 128, HTB = HALF * BK * 2  , STAGE_BYTES = 8 * HTB, NXCD = 8, WGM = 8;

__host__ __device__ __forceinline__ int lds_byte(int r, int c) { const int st = (r >> 4) * 2 + (c >> 5), rr = r & 15, cc = c & 31, ob = rr * 64 + cc * 2; return st * 1024 + (ob ^ (((ob >> 9) & 1) << 5)); }
__host__ __device__ __forceinline__ void stage_rc(int b, int& R, int& C) { const int st = b / 1024, sb = b % 1024, swz = sb ^ (((sb >> 9) & 1) << 5); R = (st >> 1) * 16 + swz / 64; C = (st & 1) * 32 + (swz % 64) / 2; }
__host__ __device__ __forceinline__ int perm32(int rho) { const int n = rho >> 4, i = rho & 15; return 8 * (i >> 2) + 4 * n + (i & 3); }

struct Unit { int pm, pn; };
struct Gemm { const bf16_t* A; const bf16_t* Bt; int M, N, K; };

struct StaticOrder {
    int nM, nN, nwg, G, c;
    __host__ __device__ void init(int M, int N, int G_, int c_) { nM = M / BM; nN = N / BM; nwg = nM * nN; G = G_; c = c_; }
    __host__ __device__ bool next(int i, Unit& u) const {
        const long L = (long)i * G + c; if (L >= nwg) return false;
        int wgid = (int)L; { const int q = nwg / NXCD, r = nwg % NXCD, xcd = wgid % NXCD, off = wgid / NXCD; wgid = (xcd < r ? xcd * (q + 1) : r * (q + 1) + (xcd - r) * q) + off; }
        const int nig = WGM * nN, gid = wgid / nig, fm = gid * WGM, gsz = (nM - fm) < WGM ? (nM - fm) : WGM;
        u.pm = fm + ((wgid % nig) % gsz); u.pn = (wgid % nig) / gsz; return true;
    }
    __device__ __forceinline__ void a_ready(const Unit&) const {}
    __device__ __forceinline__ void done(const Unit&) const {}
};

typedef float f32x2_cv __attribute__((ext_vector_type(2))); typedef __bf16 bf16x2_cv __attribute__((ext_vector_type(2)));
__device__ __forceinline__ unsigned cvt_pk_bf16(float lo, float hi) { const f32x2_cv v = {lo, hi}; const bf16x2_cv b = __builtin_convertvector(v, bf16x2_cv); return __builtin_bit_cast(unsigned, b); }
typedef float f32x2 __attribute__((ext_vector_type(2)));
template <class Epi, class Sched, bool ALIGN_EPI = false, bool SP2 = false>
__device__ __forceinline__ void gemm_phase(PG8_LAS unsigned char* lds, const Gemm g, const Sched& S, const Epi& E, const int wid) {
    int lane_; asm volatile("v_mbcnt_lo_u32_b32 %0, -1, 0\n\tv_mbcnt_hi_u32_b32 %0, -1, %0" : "=v"(lane_));
    const int lane = lane_, tid = wid * 64 + lane, wr = wid >> 2, wc = wid & 3, fr = lane & 15, fq = lane >> 4;
    const int K = g.K, nt = K / BK;
    unsigned voffA[2], voffB[2];
#pragma unroll
    for (int i = 0; i < 2; ++i) { int R, C; stage_rc(tid * 16 + i * 8192, R, C); const int Rb = Epi::PERM ? ((R & ~31) + perm32(R & 31)) : R;
        voffA[i] = (unsigned)(R * K + C) * 2u; voffB[i] = (unsigned)(Rb * K + C) * 2u; }
    const size_t kstep = (size_t)(BK * 2);
    const size_t hstep = (size_t)HALF * K * 2;
    const size_t tstep = 2 * hstep;
    const unsigned ldsw = (unsigned)wid * 1024u;
    const int aoff = lds_byte(wr * 64 + fr, fq * 8), boff = lds_byte(wc * 32 + fr, fq * 8);
#define PG8_SA(b, h) (((b) * 2 + (h)) * HTB)
#define PG8_SB(b, h) ((4 + (b) * 2 + (h)) * HTB)
#define PG8_STAGE(bufoff, gbase, voff) do { _Pragma("unroll") for (int _i = 0; _i < 2; ++_i) \
        __builtin_amdgcn_global_load_lds((const unsigned*)((const char*)(gbase) + (voff)[_i]), (PG8_LAS unsigned*)(lds + (bufoff) + ldsw + _i * 8192), 16, 0, 0); } while (0)
#define PG8_LDA(dst, b, h) do { _Pragma("unroll") for (int m = 0; m < 4; ++m) _Pragma("unroll") for (int k = 0; k < 2; ++k) dst[m][k] = *(const PG8_LAS bf16x8*)(lds + PG8_SA(b, h) + aoff + m * 2048 + k * 1024); } while (0)
#define PG8_LDB(dst, b, h) do { _Pragma("unroll") for (int n = 0; n < 2; ++n) _Pragma("unroll") for (int k = 0; k < 2; ++k) dst[n][k] = *(const PG8_LAS bf16x8*)(lds + PG8_SB(b, h) + boff + n * 2048 + k * 1024); } while (0)
#define PG8_MMA(ai, bj, At, Bt) do { __builtin_amdgcn_s_setprio(1); _Pragma("unroll") for (int m = 0; m < 4; ++m) _Pragma("unroll") for (int n = 0; n < 2; ++n) _Pragma("unroll") for (int k = 0; k < 2; ++k) \
        acc[ai][bj][m][n] = __builtin_amdgcn_mfma_f32_16x16x32_bf16(Bt[n][k], At[m][k], acc[ai][bj][m][n], 0, 0, 0); __builtin_amdgcn_s_setprio(0); } while (0)
#define PG8_WAIT_V(n) asm volatile("s_waitcnt vmcnt(" #n ")" ::: "memory")
#define PG8_WAIT_L(n) asm volatile("s_waitcnt lgkmcnt(" #n ")" ::: "memory")
#define PG8_BAR __builtin_amdgcn_s_barrier()
#define PG8_SCHED __builtin_amdgcn_sched_barrier(0)
    Unit cur, nxt; int ui = 0;
    if (!S.next(0, cur)) return;
    f32x4 acc[2][2][4][2];
#pragma unroll
    for (int a = 0; a < 2; ++a)
#pragma unroll
        for (int b = 0; b < 2; ++b)
#pragma unroll
            for (int m = 0; m < 4; ++m)
#pragma unroll
                for (int n = 0; n < 2; ++n) acc[a][b][m][n] = (f32x4){0.f, 0.f, 0.f, 0.f};
    bf16x8 At[4][2], B0[2][2], B1[2][2];
    const char* cA = (const char*)g.A + (size_t)cur.pm * tstep; const char* cB = (const char*)g.Bt + (size_t)cur.pn * tstep;
    S.a_ready(cur);
    if constexpr (SP2) {
        PG8_STAGE(PG8_SB(0, 0), cB, voffB); PG8_STAGE(PG8_SB(0, 1), cB + hstep, voffB); PG8_STAGE(PG8_SA(0, 0), cA, voffA); PG8_STAGE(PG8_SA(0, 1), cA + hstep, voffA);
        if (wr == 1) PG8_BAR;
        PG8_WAIT_V(2); PG8_BAR;
        PG8_STAGE(PG8_SB(1, 0), cB + kstep, voffB); PG8_STAGE(PG8_SA(1, 0), cA + kstep, voffA); PG8_STAGE(PG8_SB(1, 1), cB + hstep + kstep, voffB);
        PG8_WAIT_V(6); PG8_BAR;
    } else {
        PG8_STAGE(PG8_SB(0, 0), cB, voffB); PG8_STAGE(PG8_SA(0, 0), cA, voffA); PG8_STAGE(PG8_SB(0, 1), cB + hstep, voffB); PG8_STAGE(PG8_SA(0, 1), cA + hstep, voffA);
        if (wr == 1) PG8_BAR;
        PG8_WAIT_V(4); PG8_BAR;
        PG8_STAGE(PG8_SB(1, 0), cB + kstep, voffB); PG8_STAGE(PG8_SA(1, 0), cA + kstep, voffA); PG8_STAGE(PG8_SB(1, 1), cB + hstep + kstep, voffB);
        PG8_WAIT_V(6); PG8_BAR;
    }
    for (;;) {
        const bool has_next = S.next(ui + 1, nxt);
        const char* nA = has_next ? (const char*)g.A + (size_t)nxt.pm * tstep : cA; const char* nB = has_next ? (const char*)g.Bt + (size_t)nxt.pn * tstep : cB;
        for (int t = 0; t < nt; t += 2) {
            const bool last = (t == nt - 2);
            const char* a1 = cA + (size_t)(t + 1) * kstep;
            const char* a2 = last ? nA : cA + (size_t)(t + 2) * kstep; const char* b2 = last ? nB : cB + (size_t)(t + 2) * kstep;
            const char* a3 = a2 + kstep; const char* b3 = b2 + kstep;
            if (last && has_next) S.a_ready(nxt);
            if constexpr (SP2) {
            PG8_LDB(B0, 0, 0); PG8_LDB(B1, 0, 1); PG8_SCHED; PG8_LDA(At, 0, 0); PG8_STAGE(PG8_SA(1, 1), a1 + hstep, voffA);
            PG8_WAIT_V(8); PG8_WAIT_L(0); PG8_BAR; PG8_MMA(0, 0, At, B0); PG8_MMA(0, 1, At, B1); PG8_BAR; PG8_SCHED;
            PG8_LDA(At, 0, 1); PG8_STAGE(PG8_SB(0, 0), b2, voffB); PG8_STAGE(PG8_SB(0, 1), b2 + hstep, voffB); PG8_STAGE(PG8_SA(0, 0), a2, voffA);
            PG8_WAIT_V(8); PG8_WAIT_L(0); PG8_BAR; PG8_MMA(1, 0, At, B0); PG8_MMA(1, 1, At, B1); PG8_BAR; PG8_SCHED;
            PG8_LDB(B0, 1, 0); PG8_LDB(B1, 1, 1); PG8_SCHED; PG8_LDA(At, 1, 0); PG8_STAGE(PG8_SA(0, 1), a2 + hstep, voffA);
            PG8_WAIT_V(8); PG8_WAIT_L(0); PG8_BAR; PG8_MMA(0, 0, At, B0); PG8_MMA(0, 1, At, B1); PG8_BAR; PG8_SCHED;
            PG8_LDA(At, 1, 1); PG8_STAGE(PG8_SB(1, 0), b3, voffB); PG8_STAGE(PG8_SB(1, 1), b3 + hstep, voffB); PG8_STAGE(PG8_SA(1, 0), a3, voffA);
            PG8_WAIT_V(8); PG8_WAIT_L(0); PG8_BAR; PG8_MMA(1, 0, At, B0); PG8_MMA(1, 1, At, B1); PG8_BAR; PG8_SCHED;
            } else {
            PG8_LDB(B0, 0, 0); PG8_SCHED; PG8_LDA(At, 0, 0); PG8_STAGE(PG8_SA(1, 1), a1 + hstep, voffA);
            PG8_WAIT_L(8); PG8_BAR; PG8_WAIT_L(0); PG8_MMA(0, 0, At, B0); PG8_BAR; PG8_SCHED;
            PG8_LDB(B1, 0, 1); PG8_STAGE(PG8_SB(0, 0), b2, voffB);
            PG8_BAR; PG8_WAIT_L(0); PG8_MMA(0, 1, At, B1); PG8_BAR;
            PG8_LDA(At, 0, 1); PG8_STAGE(PG8_SA(0, 0), a2, voffA);
            PG8_BAR; PG8_WAIT_L(0); PG8_MMA(1, 0, At, B0); PG8_BAR; PG8_SCHED;
            PG8_STAGE(PG8_SB(0, 1), b2 + hstep, voffB);
            PG8_WAIT_V(6); PG8_BAR; PG8_MMA(1, 1, At, B1); PG8_BAR;
            PG8_LDB(B0, 1, 0); PG8_SCHED; PG8_LDA(At, 1, 0); PG8_STAGE(PG8_SA(0, 1), a2 + hstep, voffA);
            PG8_WAIT_L(8); PG8_BAR; PG8_WAIT_L(0); PG8_MMA(0, 0, At, B0); PG8_BAR; PG8_SCHED;
            PG8_LDB(B1, 1, 1); PG8_STAGE(PG8_SB(1, 0), b3, voffB);
            PG8_BAR; PG8_WAIT_L(0); PG8_MMA(0, 1, At, B1); PG8_BAR;
            PG8_LDA(At, 1, 1); PG8_STAGE(PG8_SA(1, 0), a3, voffA);
            PG8_BAR; PG8_WAIT_L(0); PG8_MMA(1, 0, At, B0); PG8_BAR; PG8_SCHED;
            PG8_STAGE(PG8_SB(1, 1), b3 + hstep, voffB);
            PG8_WAIT_V(6); PG8_BAR; PG8_MMA(1, 1, At, B1); PG8_BAR;
            }
        }
        if constexpr (ALIGN_EPI) { if (wr == 0) PG8_BAR; }
        if constexpr (!Epi::AFTER_DRAIN) { E(acc, cur, wr, wc, fr, fq); S.done(cur); }
        if (!has_next) break;
#pragma unroll
        for (int a = 0; a < 2; ++a)
#pragma unroll
            for (int b = 0; b < 2; ++b)
#pragma unroll
                for (int m = 0; m < 4; ++m)
#pragma unroll
                    for (int n = 0; n < 2; ++n) acc[a][b][m][n] = (f32x4){0.f, 0.f, 0.f, 0.f};
        cur = nxt; cA = nA; cB = nB; ++ui;
        if constexpr (ALIGN_EPI) { if (wr == 1) PG8_BAR; }
    }
    PG8_WAIT_V(0);
    if constexpr (!ALIGN_EPI) { if (wr == 0) PG8_BAR; }
    PG8_BAR;
    if constexpr (Epi::AFTER_DRAIN) { E.fused(acc, cur, wr, wc, fr, fq, lds, wid, lane); S.done(cur); }
#undef PG8_SA
#undef PG8_SB
#undef PG8_STAGE
#undef PG8_LDA
#undef PG8_LDB
#undef PG8_MMA
#undef PG8_WAIT_V
#undef PG8_WAIT_L
#undef PG8_BAR
#undef PG8_SCHED
}
}

#define LAS __attribute__((address_space(3)))
using pg8::bf16_t; using pg8::bf16x8; using pg8::f32x4; using pg8::u32x4; using pg8::Unit; using pg8::cvt_pk_bf16;
typedef float f32x16 __attribute__((ext_vector_type(16)));
typedef unsigned u32x2 __attribute__((ext_vector_type(2)));
typedef short v4i16_t __attribute__((ext_vector_type(4)));

constexpr int MP = 32 * 2048, MS = 32 * 32, MT = MP + MS;
constexpr int DIN = 3080, NQKV = 3072, DFF = 2816, PLE = 256;
constexpr int TA_S = 544, TB_S = 4128;
constexpr float EPS = 1e-6f, LOG2E = 1.4426950408889634f, QSCALE = 0.125f * LOG2E, NEGB = -1e30f;
constexpr size_t O_Y = 0, O_KA_P = (size_t)MT * 1024, O_VA_P = O_KA_P + 32u * 512 * 512, O_KB_P = O_VA_P + 32u * 512 * 512, O_VB_P = O_KB_P + (size_t)MP * 512,
                 O_LF_P = O_VB_P + (size_t)MP * 512, O_KA_S = O_LF_P + (size_t)MP * 8, O_VA_S = O_KA_S + (size_t)MS * 512, O_KB_S = O_VA_S + (size_t)MS * 512,
                 O_VB_S = O_KB_S + (size_t)MS * 512, O_LF_S = O_VB_S + (size_t)MS * 512, O_END = O_LF_S + (size_t)MS * 8;
constexpr size_t MiB = 1u << 20;
constexpr size_t WS_WQKV = 1 * MiB, WS_WO = 7 * MiB, WS_WGU = 9 * MiB, WS_WD = 20 * MiB, WS_WPG = 26 * MiB, WS_WPP = 28 * MiB, WS_GAINS = 28 * MiB + 768 * 1024, WS_RSTD0 = 29 * MiB, WS_SSQ1 = 30 * MiB, WS_SSQ2 = 35 * MiB;
constexpr size_t WS_XB = 40 * MiB, WS_PB = 170 * MiB, WS_O = 203 * MiB, WS_QKVP = 333 * MiB, WS_H = 333 * MiB;
constexpr size_t WS_QAS = 717 * MiB, WS_QBS = 718 * MiB, WS_KAN = 719 * MiB, WS_VAN = 720 * MiB, WS_KBN = 721 * MiB, WS_VBN = 722 * MiB, WS_PP = 723 * MiB, WS_END = 853 * MiB;
constexpr size_t PSTRIDE = (size_t)32 * 8 * 2048 * 64;
constexpr int LDS_BYTES = 147456;

struct Args { const float* in[25]; float* out; unsigned char* ws; int ph_lo, ph_hi; };

__device__ __forceinline__ int lane_id_fresh() { int l; asm volatile("v_mbcnt_lo_u32_b32 %0, -1, 0\n\tv_mbcnt_hi_u32_b32 %0, -1, %0" : "=v"(l)); return l; }
__device__ __forceinline__ float wave_sum(float v) {
#pragma unroll
    for (int o = 1; o < 64; o <<= 1) v += __shfl_xor(v, o);
    return v;
}
__device__ __forceinline__ float bf_lo(unsigned u) { return __uint_as_float(u << 16); }
__device__ __forceinline__ float bf_hi(unsigned u) { return __uint_as_float(u & 0xffff0000u); }
__device__ __forceinline__ float fast_rcp(float x) { return __builtin_amdgcn_rcpf(x); }
__device__ __forceinline__ float fast_exp2(float x) { return __builtin_amdgcn_exp2f(x); }

struct EpiQKV {
    static constexpr bool PERM = true, AFTER_DRAIN = false;
    const float* rstd0; const float* gains; unsigned char* ws; float* out;
    __device__ __forceinline__ void operator()(const f32x4 (&acc)[2][2][4][2], const Unit& u, int wr, int wc, int fr, int fq) const {
        const int kind = u.pn >> 1, head = ((u.pn & 1) << 2) + wc, sub = kind % 3; const bool isB = kind >= 3;
        f32x4 gn[2][2];
        if (sub != 2) { const float* gp = gains + ((isB ? 2 : 0) + sub) * 64; const float sc = sub == 0 ? QSCALE : 1.0f;
#pragma unroll
            for (int bj = 0; bj < 2; ++bj)
#pragma unroll
                for (int n = 0; n < 2; ++n) gn[bj][n] = *(const f32x4*)(gp + 32 * bj + 8 * fq + 4 * n) * sc; }
        else { gn[0][0] = gn[0][1] = gn[1][0] = gn[1][1] = (f32x4){1.f, 1.f, 1.f, 1.f}; }
#pragma unroll
        for (int ai = 0; ai < 2; ++ai)
#pragma unroll
            for (int m = 0; m < 4; ++m) {
                const int rl = ai * 128 + wr * 64 + m * 16 + fr, row = u.pm * 256 + rl;
                const float rs = rstd0[row];
                f32x4 v[2][2];
#pragma unroll
                for (int bj = 0; bj < 2; ++bj)
#pragma unroll
                    for (int n = 0; n < 2; ++n) v[bj][n] = acc[ai][bj][m][n] * rs;
                if (sub != 2) {
                    float ss = 0.f;
#pragma unroll
                    for (int bj = 0; bj < 2; ++bj)
#pragma unroll
                        for (int n = 0; n < 2; ++n) { const f32x4 x = v[bj][n]; ss += (x[0] * x[0] + x[1] * x[1]) + (x[2] * x[2] + x[3] * x[3]); }
                    ss += __shfl_xor(ss, 16); ss += __shfl_xor(ss, 32);
                    const float hr = rsqrtf(ss * (1.0f / 64.0f) + EPS);
#pragma unroll
                    for (int bj = 0; bj < 2; ++bj)
#pragma unroll
                        for (int n = 0; n < 2; ++n) v[bj][n] = v[bj][n] * hr * gn[bj][n];
                }
                bf16_t* dst; float* fo = nullptr;
                if (u.pm < 256) {
                    const int b = u.pm >> 3, t = ((u.pm & 7) << 8) + rl;
                    dst = (bf16_t*)(ws + WS_QKVP) + (size_t)kind * PSTRIDE + ((size_t)(b * 8 + head) * 2048 + t) * 64;
                    if (sub != 0) {
                        if (isB) fo = out + (sub == 1 ? O_KB_P : O_VB_P) + ((size_t)(b * 2048 + t) * 8 + head) * 64;
                        else if (t >= 1536) fo = out + (sub == 1 ? O_KA_P : O_VA_P) + ((size_t)(b * 512 + (t - 1536)) * 8 + head) * 64;
                    }
                } else {
                    const int rp = (u.pm - 256) * 256 + rl, b = rp >> 5, t = rp & 31;
                    if (sub == 0) dst = (bf16_t*)(ws + (isB ? WS_QBS : WS_QAS)) + ((size_t)(b * 8 + head) * 32 + t) * 64;
                    else if (!isB) { dst = (bf16_t*)(ws + (sub == 1 ? WS_KAN : WS_VAN)) + ((size_t)(b * 8 + head) * 32 + t) * 64;
                                     fo = out + (sub == 1 ? O_KA_S : O_VA_S) + ((size_t)(b * 32 + t) * 8 + head) * 64; }
                    else { dst = (bf16_t*)(ws + (sub == 1 ? WS_KBN : WS_VBN)) + ((size_t)(b * 8 + head) * 32 + t) * 64;
                           fo = out + (sub == 1 ? O_KB_S : O_VB_S) + ((size_t)(b * 32 + t) * 8 + head) * 64; }
                }
#pragma unroll
                for (int bj = 0; bj < 2; ++bj) {
                    const int col = 32 * bj + 8 * fq; const f32x4 v0 = v[bj][0], v1 = v[bj][1];
                    u32x4 w; w.x = cvt_pk_bf16(v0[0], v0[1]); w.y = cvt_pk_bf16(v0[2], v0[3]); w.z = cvt_pk_bf16(v1[0], v1[1]); w.w = cvt_pk_bf16(v1[2], v1[3]);
                    *(u32x4*)(dst + col) = w;
                    if (fo) { *(f32x4*)(fo + col) = v0; *(f32x4*)(fo + col + 4) = v1; }
                }
            }
    }
};
struct EpiStore {
    static constexpr bool PERM = true, AFTER_DRAIN = false;
    bf16_t* O; int ldc;
    __device__ __forceinline__ void operator()(const f32x4 (&acc)[2][2][4][2], const Unit& u, int wr, int wc, int fr, int fq) const {
#pragma unroll
        for (int ai = 0; ai < 2; ++ai)
#pragma unroll
            for (int m = 0; m < 4; ++m) { const int row = u.pm * 256 + ai * 128 + wr * 64 + m * 16 + fr;
#pragma unroll
                for (int bj = 0; bj < 2; ++bj) { const int col = u.pn * 256 + 128 * bj + 32 * wc + 8 * fq; const f32x4 v0 = acc[ai][bj][m][0], v1 = acc[ai][bj][m][1];
                    u32x4 w; w.x = cvt_pk_bf16(v0[0], v0[1]); w.y = cvt_pk_bf16(v0[2], v0[3]); w.z = cvt_pk_bf16(v1[0], v1[1]); w.w = cvt_pk_bf16(v1[2], v1[3]);
                    *(u32x4*)(O + (size_t)row * ldc + col) = w; } }
    }
};
template <bool F32BASE> struct EpiRes {
    static constexpr bool PERM = true, AFTER_DRAIN = false;
    const float* base_p; const float* base_s; bf16_t* xb; float* ssq;
    __device__ __forceinline__ void operator()(const f32x4 (&acc)[2][2][4][2], const Unit& u, int wr, int wc, int fr, int fq) const {
#pragma unroll
        for (int ai = 0; ai < 2; ++ai)
#pragma unroll
            for (int m = 0; m < 4; ++m) { const int row = u.pm * 256 + ai * 128 + wr * 64 + m * 16 + fr;
                const float* bp = (u.pm < 256) ? base_p + (size_t)row * 1024 : base_s + (size_t)(row - MP) * 1024;
                float s = 0.f;
#pragma unroll
                for (int bj = 0; bj < 2; ++bj) { const int col = u.pn * 256 + 128 * bj + 32 * wc + 8 * fq;
                    f32x4 r0, r1;
                    if (F32BASE) { r0 = *(const f32x4*)(bp + col); r1 = *(const f32x4*)(bp + col + 4); }
                    else { const u32x4 rw = *(const u32x4*)(xb + (size_t)row * 1024 + col); r0 = (f32x4){bf_lo(rw.x), bf_hi(rw.x), bf_lo(rw.y), bf_hi(rw.y)}; r1 = (f32x4){bf_lo(rw.z), bf_hi(rw.z), bf_lo(rw.w), bf_hi(rw.w)}; }
                    const f32x4 v0 = acc[ai][bj][m][0] + r0, v1 = acc[ai][bj][m][1] + r1;
                    u32x4 w; w.x = cvt_pk_bf16(v0[0], v0[1]); w.y = cvt_pk_bf16(v0[2], v0[3]); w.z = cvt_pk_bf16(v1[0], v1[1]); w.w = cvt_pk_bf16(v1[2], v1[3]);
                    *(u32x4*)(xb + (size_t)row * 1024 + col) = w;
                    s += (v0[0] * v0[0] + v0[1] * v0[1]) + (v0[2] * v0[2] + v0[3] * v0[3]) + (v1[0] * v1[0] + v1[1] * v1[1]) + (v1[2] * v1[2] + v1[3] * v1[3]); }
                s += __shfl_xor(s, 16); s += __shfl_xor(s, 32);
                if (fq == 0) ssq[(size_t)row * 16 + u.pn * 4 + wc] = s; }
    }
};
__device__ __forceinline__ float row_rstd(const float* ssq, int row) {
    const f32x4 a = *(const f32x4*)(ssq + (size_t)row * 16), b = *(const f32x4*)(ssq + (size_t)row * 16 + 4), c = *(const f32x4*)(ssq + (size_t)row * 16 + 8), d = *(const f32x4*)(ssq + (size_t)row * 16 + 12);
    const float t = ((a[0] + a[1]) + (a[2] + a[3])) + ((b[0] + b[1]) + (b[2] + b[3])) + ((c[0] + c[1]) + (c[2] + c[3])) + ((d[0] + d[1]) + (d[2] + d[3]));
    return rsqrtf(t * (1.0f / 1024.0f) + EPS);
}
struct EpiSwiGLU {
    static constexpr bool PERM = true, AFTER_DRAIN = false;
    const float* ssq; bf16_t* H;
    __device__ __forceinline__ void operator()(const f32x4 (&acc)[2][2][4][2], const Unit& u, int wr, int wc, int fr, int fq) const {
#pragma unroll
        for (int ai = 0; ai < 2; ++ai)
#pragma unroll
            for (int m = 0; m < 4; ++m) { const int row = u.pm * 256 + ai * 128 + wr * 64 + m * 16 + fr; const float rs = row_rstd(ssq, row);
                float hv[8];
#pragma unroll
                for (int n = 0; n < 2; ++n)
#pragma unroll
                    for (int e = 0; e < 4; ++e) { const float g = acc[ai][0][m][n][e] * rs, up = acc[ai][1][m][n][e] * rs;
                        hv[4 * n + e] = g * up * fast_rcp(1.0f + fast_exp2(-g * LOG2E)); }
                u32x4 w; w.x = cvt_pk_bf16(hv[0], hv[1]); w.y = cvt_pk_bf16(hv[2], hv[3]); w.z = cvt_pk_bf16(hv[4], hv[5]); w.w = cvt_pk_bf16(hv[6], hv[7]);
                *(u32x4*)(H + (size_t)row * DFF + u.pn * 128 + 32 * wc + 8 * fq) = w; }
    }
};
struct EpiPle {
    static constexpr bool PERM = true, AFTER_DRAIN = false;
    const float* ssq; const bf16_t* PP; const bf16_t* xb; float* y;
    __device__ __forceinline__ void operator()(const f32x4 (&acc)[2][2][4][2], const Unit& u, int wr, int wc, int fr, int fq) const {
#pragma unroll
        for (int ai = 0; ai < 2; ++ai)
#pragma unroll
            for (int m = 0; m < 4; ++m) { const int row = u.pm * 256 + ai * 128 + wr * 64 + m * 16 + fr; const float rs = row_rstd(ssq, row);
#pragma unroll
                for (int bj = 0; bj < 2; ++bj) { const int col = u.pn * 256 + 128 * bj + 32 * wc + 8 * fq; float* yp = y + (size_t)row * 1024 + col;
                    const u32x4 pw = *(const u32x4*)(PP + (size_t)row * 1024 + col);
                    const u32x4 xw = *(const u32x4*)(xb + (size_t)row * 1024 + col);
                    const f32x4 x0 = (f32x4){bf_lo(xw.x), bf_hi(xw.x), bf_lo(xw.y), bf_hi(xw.y)}, x1 = (f32x4){bf_lo(xw.z), bf_hi(xw.z), bf_lo(xw.w), bf_hi(xw.w)};
                    const f32x4 a0 = acc[ai][bj][m][0] * rs, a1 = acc[ai][bj][m][1] * rs;
                    f32x4 o0, o1;
                    o0[0] = x0[0] + bf_lo(pw.x) * fast_rcp(1.0f + fast_exp2(-a0[0] * LOG2E)); o0[1] = x0[1] + bf_hi(pw.x) * fast_rcp(1.0f + fast_exp2(-a0[1] * LOG2E));
                    o0[2] = x0[2] + bf_lo(pw.y) * fast_rcp(1.0f + fast_exp2(-a0[2] * LOG2E)); o0[3] = x0[3] + bf_hi(pw.y) * fast_rcp(1.0f + fast_exp2(-a0[3] * LOG2E));
                    o1[0] = x1[0] + bf_lo(pw.z) * fast_rcp(1.0f + fast_exp2(-a1[0] * LOG2E)); o1[1] = x1[1] + bf_hi(pw.z) * fast_rcp(1.0f + fast_exp2(-a1[1] * LOG2E));
                    o1[2] = x1[2] + bf_lo(pw.w) * fast_rcp(1.0f + fast_exp2(-a1[2] * LOG2E)); o1[3] = x1[3] + bf_hi(pw.w) * fast_rcp(1.0f + fast_exp2(-a1[3] * LOG2E));
                    *(f32x4*)yp = o0; *(f32x4*)(yp + 4) = o1; } }
    }
};

__device__ __forceinline__ void tr_item(const float* W, int ldw, int K, int srccol0, bf16_t* WT, int dstrow0, const float* gain, LAS float* scr, int kb, int lane) {
    const int k0 = 64 * kb;
#pragma unroll 8
    for (int i = 0; i < 32; ++i) { const int kk = 2 * i + (lane >> 5); float v = W[(size_t)(k0 + kk) * ldw + srccol0 + (lane & 31)]; if (gain) v *= gain[k0 + kk]; scr[kk * 33 + (lane & 31)] = v; }
    asm volatile("s_waitcnt lgkmcnt(0)" ::: "memory");
    const int c = lane & 7;
#pragma unroll
    for (int j = 0; j < 4; ++j) { const int n = (lane >> 3) + 8 * j; const LAS float* s = scr + (8 * c) * 33 + n;
        u32x4 o; o.x = cvt_pk_bf16(s[0 * 33], s[1 * 33]); o.y = cvt_pk_bf16(s[2 * 33], s[3 * 33]); o.z = cvt_pk_bf16(s[4 * 33], s[5 * 33]); o.w = cvt_pk_bf16(s[6 * 33], s[7 * 33]);
        *(u32x4*)(WT + (size_t)(dstrow0 + n) * K + k0 + 8 * c) = o; }
    asm volatile("s_waitcnt lgkmcnt(0)" ::: "memory");
}
__device__ __forceinline__ void cvt8(const float* src, bf16_t* dst) {
    const f32x4 a = *(const f32x4*)src, b = *(const f32x4*)(src + 4);
    u32x4 w; w.x = cvt_pk_bf16(a[0], a[1]); w.y = cvt_pk_bf16(a[2], a[3]); w.z = cvt_pk_bf16(b[0], b[1]); w.w = cvt_pk_bf16(b[2], b[3]);
    *(u32x4*)dst = w;
}
__device__ __forceinline__ void tr_set(const Args& a, LAS unsigned char* lds, int wave, int lane, const int set, int gw, int NGW) {
    unsigned char* ws = a.ws;
    LAS float* scr = (LAS float*)(lds + wave * 16384);
    constexpr int I_QKV = 16 * 96, I_O = 16 * 32, I_GU = 16 * 176, I_D = 44 * 32, I_PG = 16 * 32, I_PP = 4 * 32;
    const int ntot = set == 0 ? I_QKV : (set == 1 ? I_O + I_GU : I_D + I_PG + I_PP);
    for (int it = gw; it < ntot; it += NGW) {
        int r = it;
        if (set == 0) { const int kb = r / 96, nb = r % 96, pn = nb >> 3, bj = (nb >> 2) & 1, wc = nb & 3;
            tr_item(a.in[10], DIN, 1024, 256 * pn + 64 * wc + 32 * bj, (bf16_t*)(ws + WS_WQKV), 32 * nb, a.in[9], scr, kb, lane); continue; }
        if (set == 1) {
            if (r < I_O) { const int kb = r / 32, nb = r % 32; tr_item(a.in[17], 1024, 1024, 32 * nb, (bf16_t*)(ws + WS_WO), 32 * nb, nullptr, scr, kb, lane); continue; } r -= I_O;
            { const int kb = r / 176, nb = r % 176, pn = nb >> 3, bj = (nb >> 2) & 1, q = nb & 3;
              tr_item(bj ? a.in[20] : a.in[19], DFF, 1024, 128 * pn + 32 * q, (bf16_t*)(ws + WS_WGU), 32 * nb, a.in[18], scr, kb, lane); continue; }
        }
        if (r < I_D) { const int kb = r / 32, nb = r % 32; tr_item(a.in[21], 1024, DFF, 32 * nb, (bf16_t*)(ws + WS_WD), 32 * nb, nullptr, scr, kb, lane); continue; } r -= I_D;
        if (r < I_PG) { const int kb = r / 32, nb = r % 32; tr_item(a.in[23], 1024, 1024, 32 * nb, (bf16_t*)(ws + WS_WPG), 32 * nb, a.in[22], scr, kb, lane); continue; } r -= I_PG;
        { const int kb = r / 32, nb = r % 32; tr_item(a.in[24], 1024, PLE, 32 * nb, (bf16_t*)(ws + WS_WPP), 32 * nb, nullptr, scr, kb, lane); }
    }
}
__device__ __forceinline__ void shadow_share(int nu, int G, int c, int& rank, int& count) {
    const int tailc = nu - (nu / G) * G; const bool split = tailc > 0 && tailc * 2 < G;
    if (!split) { rank = c; count = G; } else if (c >= tailc) { rank = c - tailc; count = G - tailc; } else { rank = 0; count = 0; }
}
__device__ __forceinline__ void p_convert(const Args& a, const size_t gt, const size_t NT) {
    unsigned char* ws = a.ws;
    for (size_t i0 = gt; i0 < (size_t)MT * 32; i0 += 4 * NT) {
        f32x4 r[4][2];
#pragma unroll
        for (int q = 0; q < 4; ++q) { const size_t i = i0 + q * NT; if (i < (size_t)MT * 32) { const size_t row = i >> 5; const int c8 = (int)(i & 31);
            const float* src = row < (size_t)MP ? a.in[7] + row * 256 + c8 * 8 : a.in[8] + (row - MP) * 256 + c8 * 8; r[q][0] = __builtin_nontemporal_load((const f32x4*)src); r[q][1] = __builtin_nontemporal_load((const f32x4*)(src + 4)); } }
#pragma unroll
        for (int q = 0; q < 4; ++q) { const size_t i = i0 + q * NT; if (i < (size_t)MT * 32) {
            u32x4 w; w.x = cvt_pk_bf16(r[q][0][0], r[q][0][1]); w.y = cvt_pk_bf16(r[q][0][2], r[q][0][3]); w.z = cvt_pk_bf16(r[q][1][0], r[q][1][1]); w.w = cvt_pk_bf16(r[q][1][2], r[q][1][3]);
            *(u32x4*)((bf16_t*)(ws + WS_PB) + i * 8) = w; } }
    }
}
__device__ __forceinline__ void phase0(const Args& a, LAS unsigned char* lds, int wave) {
    const int lane = lane_id_fresh(), tid = wave * 64 + lane;
    unsigned char* ws = a.ws;
    const int gw = blockIdx.x * 8 + wave, NGW = gridDim.x * 8;
    tr_set(a, lds, wave, lane, 0, gw, NGW);
    if (blockIdx.x == 0 && tid < 256) { const int w = tid >> 6, d = tid & 63; ((float*)(ws + WS_GAINS))[tid] = a.in[12 + w][d]; }
    if (blockIdx.x == 0 && wave == 0) {
        float ga = fabsf(a.in[12][lane]), ka = fabsf(a.in[13][lane]), gb = fabsf(a.in[14][lane]), kb = fabsf(a.in[15][lane]);
#pragma unroll
        for (int o = 1; o < 64; o <<= 1) { ga = fmaxf(ga, __shfl_xor(ga, o)); ka = fmaxf(ka, __shfl_xor(ka, o)); gb = fmaxf(gb, __shfl_xor(gb, o)); kb = fmaxf(kb, __shfl_xor(kb, o)); }
        if (lane == 0) { ((float*)(ws + WS_GAINS))[256] = 64.0f * QSCALE * ga * ka + 1.0f; ((float*)(ws + WS_GAINS))[257] = 64.0f * QSCALE * gb * kb + 1.0f; }
    }
    if (blockIdx.x == 0) {
        const float* tb = a.in[16] + wave * 257;
        float mx = fmaxf(fmaxf(tb[lane], tb[lane + 64]), fmaxf(tb[lane + 128], tb[lane + 192])); mx = fmaxf(mx, tb[256]);
#pragma unroll
        for (int o = 1; o < 64; o <<= 1) mx = fmaxf(mx, __shfl_xor(mx, o));
        if (lane == 0) ((float*)(ws + WS_GAINS))[264 + wave] = mx;
    }
    __syncthreads();
    {
        LAS float* wf = (LAS float*)lds;
        for (int i = tid; i < 8192; i += 512) { const int j = i >> 10, k = i & 1023; wf[i] = a.in[9][k] * a.in[10][(size_t)k * DIN + 3072 + j]; }
        __syncthreads();
        f32x4 wr[8][4];
#pragma unroll
        for (int jj = 0; jj < 8; ++jj)
#pragma unroll
            for (int j = 0; j < 4; ++j) wr[jj][j] = *(const LAS f32x4*)(wf + jj * 1024 + (lane + 64 * j) * 4);
        for (int row0 = gw; row0 < MT; row0 += 2 * NGW) {
            f32x4 vv[2][4];
#pragma unroll
            for (int rr = 0; rr < 2; ++rr) { const int row = row0 + rr * NGW < MT ? row0 + rr * NGW : row0;
                const float* xr = row < MP ? a.in[0] + (size_t)row * 1024 : a.in[1] + (size_t)(row - MP) * 1024;
#pragma unroll
                for (int j = 0; j < 4; ++j) vv[rr][j] = __builtin_nontemporal_load((const f32x4*)xr + lane + 64 * j); }
#pragma unroll
            for (int rr = 0; rr < 2; ++rr) {
                const int row = row0 + rr * NGW;
                if (row >= MT) break;
                f32x4 v[4];
#pragma unroll
                for (int j = 0; j < 4; ++j) v[j] = vv[rr][j];
                float ss = 0.f;
#pragma unroll
                for (int j = 0; j < 4; ++j) ss += (v[j][0] * v[j][0] + v[j][1] * v[j][1]) + (v[j][2] * v[j][2] + v[j][3] * v[j][3]);
                u32x2* xo = (u32x2*)((bf16_t*)(ws + WS_XB) + (size_t)row * 1024);
#pragma unroll
                for (int j = 0; j < 4; ++j) { u32x2 w; w.x = cvt_pk_bf16(v[j][0], v[j][1]); w.y = cvt_pk_bf16(v[j][2], v[j][3]); xo[lane + 64 * j] = w; }
                float d[8];
#pragma unroll
                for (int jj = 0; jj < 8; ++jj) { float t = 0.f;
#pragma unroll
                    for (int j = 0; j < 4; ++j) { const f32x4 w = wr[jj][j]; t += (v[j][0] * w[0] + v[j][1] * w[1]) + (v[j][2] * w[2] + v[j][3] * w[3]); }
                    d[jj] = t; }
                const bool b5 = (lane & 32) != 0, b4 = (lane & 16) != 0, b3 = (lane & 8) != 0;
                float e4[4], e2[2];
#pragma unroll
                for (int j = 0; j < 4; ++j) { const float snd = b5 ? d[j] : d[j + 4], kp = b5 ? d[j + 4] : d[j]; e4[j] = kp + __shfl_xor(snd, 32); }
#pragma unroll
                for (int j = 0; j < 2; ++j) { const float snd = b4 ? e4[j] : e4[j + 2], kp = b4 ? e4[j + 2] : e4[j]; e2[j] = kp + __shfl_xor(snd, 16); }
                float g; { const float snd = b3 ? e2[0] : e2[1], kp = b3 ? e2[1] : e2[0]; g = kp + __shfl_xor(snd, 8); }
                g += __shfl_xor(g, 4); g += __shfl_xor(g, 2); g += __shfl_xor(g, 1);
                const float rstd = rsqrtf(wave_sum(ss) * (1.0f / 1024.0f) + EPS);
                if ((lane & 7) == 0) { const int k = lane >> 3; g = g * rstd + a.in[11][k]; const float lf = fminf(g, 0.f) - log1pf(expf(-fabsf(g)));
                    float* dst = row < MP ? a.out + O_LF_P + (size_t)row * 8 : a.out + O_LF_S + (size_t)(row - MP) * 8; dst[k] = lf; }
                if (lane == 0) ((float*)(ws + WS_RSTD0))[row] = rstd;
            }
        }
    }
}

__device__ __forceinline__ int crow(int r, int hi) { return (r & 3) + 8 * (r >> 2) + 4 * hi; }
__device__ __forceinline__ void split3(float t, unsigned& h, unsigned& m, unsigned& l) {
    h = cvt_pk_bf16(t, 0.f) & 0xffffu; const float r1 = t - __uint_as_float(h << 16);
    m = cvt_pk_bf16(r1, 0.f) & 0xffffu; const float r2 = r1 - __uint_as_float(m << 16);
    l = cvt_pk_bf16(r2, 0.f) & 0xffffu;
}
__device__ __forceinline__ float qk_bound(const unsigned char* ws, const bool modeB, int lane) {
    (void)lane; return *(volatile const float*)((const float*)(ws + WS_GAINS) + 256 + (modeB ? 1 : 0));
}
__device__ __forceinline__ bf16x8 pack8(float a0, float a1, float a2, float a3, float a4, float a5, float a6, float a7) {
    u32x4 w; w.x = cvt_pk_bf16(a0, a1); w.y = cvt_pk_bf16(a2, a3); w.z = cvt_pk_bf16(a4, a5); w.w = cvt_pk_bf16(a6, a7); return __builtin_bit_cast(bf16x8, w);
}
constexpr int A_KS = 0, A_VS = 36864, A_TAB = 73728, A_TSP = 81920, A_WSF = 98304, A_SCAN = 100352, KVT = 128 * 72;
__device__ __forceinline__ void attn_tile(const LAS bf16_t* Kt, const LAS bf16_t* Vt, const bf16x8 (&qr)[4], const LAS float* tab, LAS float* wsf, const bool modeB, const int kb0, const int qw,
                                          const int lane, f32x16& o0, f32x16& o1, float& mrun, float& lrun, const bf16x8 bq = (bf16x8){0, 0, 0, 0, 0, 0, 0, 0}, const LAS u32x2* tsp = nullptr) {
    const int r32 = lane & 31, hi = lane >> 5, qa = qw + r32;
    bf16x8 kf0[4], kf1[4];
#pragma unroll
    for (int d0 = 0; d0 < 4; ++d0) { kf0[d0] = *(const LAS bf16x8*)(Kt + r32 * 72 + d0 * 16 + hi * 8); kf1[d0] = *(const LAS bf16x8*)(Kt + (32 + r32) * 72 + d0 * 16 + hi * 8); }
    const LAS bf16_t* vb = Vt + (4 * hi + ((lane & 15) >> 2)) * 72 + 16 * ((lane >> 4) & 1) + 4 * (lane & 3);
    v4i16_t vlo[8], vup[8];
#pragma unroll
    for (int g = 0; g < 4; ++g)
#pragma unroll
        for (int d0 = 0; d0 < 2; ++d0) {
            vlo[2 * g + d0] = __builtin_amdgcn_ds_read_tr16_b64_v4i16((LAS v4i16_t*)(vb + (16 * g) * 72 + 32 * d0));
            vup[2 * g + d0] = __builtin_amdgcn_ds_read_tr16_b64_v4i16((LAS v4i16_t*)(vb + (16 * g + 8) * 72 + 32 * d0)); }
    f32x16 p0, p1;
    bf16x8 ab0, ab1;
    if (modeB) {
        const u32x2 t0 = tsp[kb0 + r32], t1 = tsp[kb0 + 32 + r32];
        ab0 = __builtin_bit_cast(bf16x8, (u32x4){t0.x, t0.y, 0x3F803F80u, 0u}); ab1 = __builtin_bit_cast(bf16x8, (u32x4){t1.x, t1.y, 0x3F803F80u, 0u});
#pragma unroll
        for (int r = 0; r < 16; ++r) { p0[r] = 0.f; p1[r] = 0.f; }
    } else {
        if (qw - (kb0 + 63) >= 128) { const float c = tab[256];
#pragma unroll
            for (int r = 0; r < 16; ++r) { p0[r] = c; p1[r] = c; } }
        else {
#pragma unroll
            for (int r = 0; r < 16; ++r) { const int rel = qa - (kb0 + crow(r, hi)); int i0 = rel < -128 ? -128 : rel; i0 = i0 > 128 ? 128 : i0; int i1 = rel - 32 < -128 ? -128 : rel - 32; i1 = i1 > 128 ? 128 : i1;
                p0[r] = tab[i0 + 128]; p1[r] = tab[i1 + 128]; } }
    }
    if (modeB) { p0 = __builtin_amdgcn_mfma_f32_32x32x16_bf16(ab0, bq, p0, 0, 0, 0); p1 = __builtin_amdgcn_mfma_f32_32x32x16_bf16(ab1, bq, p1, 0, 0, 0); }
#pragma unroll
    for (int d0 = 0; d0 < 4; ++d0) {
        p0 = __builtin_amdgcn_mfma_f32_32x32x16_bf16(kf0[d0], qr[d0], p0, 0, 0, 0);
        p1 = __builtin_amdgcn_mfma_f32_32x32x16_bf16(kf1[d0], qr[d0], p1, 0, 0, 0);
    }
    if (modeB && kb0 + 63 > qw) {
#pragma unroll
        for (int r = 0; r < 16; ++r) { const int kk = kb0 + crow(r, hi); if (kk > qa) p0[r] = NEGB; if (kk + 32 > qa) p1[r] = NEGB; } }
    float sum = 0.f;
#pragma unroll
    for (int r = 0; r < 16; ++r) { p0[r] = fast_exp2(p0[r]); p1[r] = fast_exp2(p1[r]); sum += p0[r] + p1[r]; }
    lrun += sum;
    bf16x8 pa[4];
    pa[0] = pack8(p0[0], p0[1], p0[2], p0[3], p0[4], p0[5], p0[6], p0[7]); pa[1] = pack8(p0[8], p0[9], p0[10], p0[11], p0[12], p0[13], p0[14], p0[15]);
    pa[2] = pack8(p1[0], p1[1], p1[2], p1[3], p1[4], p1[5], p1[6], p1[7]); pa[3] = pack8(p1[8], p1[9], p1[10], p1[11], p1[12], p1[13], p1[14], p1[15]);
#pragma unroll
    for (int g = 0; g < 4; ++g) {
#pragma unroll
        for (int d0 = 0; d0 < 2; ++d0) {
            const v4i16_t lo = vlo[2 * g + d0], up = vup[2 * g + d0];
            const bf16x8 vf = (bf16x8){lo[0], lo[1], lo[2], lo[3], up[0], up[1], up[2], up[3]};
            if (d0 == 0) o0 = __builtin_amdgcn_mfma_f32_32x32x16_bf16(pa[g], vf, o0, 0, 0, 0);
            else         o1 = __builtin_amdgcn_mfma_f32_32x32x16_bf16(pa[g], vf, o1, 0, 0, 0);
        }
    }
}
__device__ __forceinline__ void attn_bias_init(f32x16& p0, f32x16& p1, const LAS float* tab, const bool modeB, const int kb0, const int qw, const int qa, const int hi) {
    if (modeB) {
#pragma unroll
        for (int rg = 0; rg < 4; ++rg) { const f32x4 c0 = *(const LAS f32x4*)(tab + kb0 + 8 * rg + 4 * hi), c1 = *(const LAS f32x4*)(tab + kb0 + 32 + 8 * rg + 4 * hi);
#pragma unroll
            for (int i = 0; i < 4; ++i) { p0[4 * rg + i] = c0[i]; p1[4 * rg + i] = c1[i]; } }
    } else if (qw - (kb0 + 63) >= 128) { const float c = tab[256];
#pragma unroll
        for (int r = 0; r < 16; ++r) { p0[r] = c; p1[r] = c; }
    } else {
#pragma unroll
        for (int r = 0; r < 16; ++r) { const int rel = qa - (kb0 + crow(r, hi)); int i0 = rel < -128 ? -128 : rel; i0 = i0 > 128 ? 128 : i0; int i1 = rel - 32 < -128 ? -128 : rel - 32; i1 = i1 > 128 ? 128 : i1;
            p0[r] = tab[i0 + 128]; p1[r] = tab[i1 + 128]; }
    }
}
__device__ __forceinline__ void attn_softmax_pv(f32x16& p0, f32x16& p1, const LAS bf16_t* Vt, LAS float* wsf, const int lane, f32x16& o0, f32x16& o1, float& mrun, float& lrun) {
    const int r32 = lane & 31, hi = lane >> 5;
    float mx = fmaxf(p0[0], p1[0]);
#pragma unroll
    for (int r = 1; r < 16; ++r) mx = fmaxf(mx, fmaxf(p0[r], p1[r]));
    mx = fmaxf(mx, __shfl_xor(mx, 32));
    const float mnew = fmaxf(mrun, mx), alpha = fast_exp2(mrun - mnew); mrun = mnew;
    wsf[r32] = alpha;
    float sum = 0.f;
#pragma unroll
    for (int r = 0; r < 16; ++r) { p0[r] = fast_exp2(p0[r] - mnew); p1[r] = fast_exp2(p1[r] - mnew); sum += p0[r] + p1[r]; }
    lrun = lrun * alpha + sum;
#pragma unroll
    for (int rg = 0; rg < 4; ++rg) { const f32x4 f = *(const LAS f32x4*)(wsf + 8 * rg + 4 * hi);
#pragma unroll
        for (int i = 0; i < 4; ++i) { o0[4 * rg + i] *= f[i]; o1[4 * rg + i] *= f[i]; } }
    bf16x8 pa[4];
    pa[0] = pack8(p0[0], p0[1], p0[2], p0[3], p0[4], p0[5], p0[6], p0[7]); pa[1] = pack8(p0[8], p0[9], p0[10], p0[11], p0[12], p0[13], p0[14], p0[15]);
    pa[2] = pack8(p1[0], p1[1], p1[2], p1[3], p1[4], p1[5], p1[6], p1[7]); pa[3] = pack8(p1[8], p1[9], p1[10], p1[11], p1[12], p1[13], p1[14], p1[15]);
    const LAS bf16_t* vb = Vt + (4 * hi + ((lane & 15) >> 2)) * 72 + 16 * ((lane >> 4) & 1) + 4 * (lane & 3);
#pragma unroll
    for (int g = 0; g < 4; ++g) {
#pragma unroll
        for (int d0 = 0; d0 < 2; ++d0) {
            const v4i16_t lo = __builtin_amdgcn_ds_read_tr16_b64_v4i16((LAS v4i16_t*)(vb + (16 * g) * 72 + 32 * d0));
            const v4i16_t up = __builtin_amdgcn_ds_read_tr16_b64_v4i16((LAS v4i16_t*)(vb + (16 * g + 8) * 72 + 32 * d0));
            const bf16x8 vf = (bf16x8){lo[0], lo[1], lo[2], lo[3], up[0], up[1], up[2], up[3]};
            if (d0 == 0) o0 = __builtin_amdgcn_mfma_f32_32x32x16_bf16(pa[g], vf, o0, 0, 0, 0);
            else         o1 = __builtin_amdgcn_mfma_f32_32x32x16_bf16(pa[g], vf, o1, 0, 0, 0);
        }
    }
}
__device__ __forceinline__ void attn_pair(const LAS bf16_t* Kt, const LAS bf16_t* Vt, const bf16x8 (&qr)[4], const LAS float* tab, LAS float* wsf, const bool modeB, const int kb0, const int qw,
                                          const int lane, f32x16& o0, f32x16& o1, float& mrun, float& lrun) {
    const int r32 = lane & 31, hi = lane >> 5, qa = qw + r32;
    f32x16 a0, a1, b0, b1;
    attn_bias_init(a0, a1, tab, modeB, kb0, qw, qa, hi); attn_bias_init(b0, b1, tab, modeB, kb0 + 64, qw, qa, hi);
#pragma unroll
    for (int d0 = 0; d0 < 4; ++d0) {
        const LAS bf16_t* kp = Kt + r32 * 72 + d0 * 16 + hi * 8;
        const bf16x8 k0 = *(const LAS bf16x8*)(kp), k1 = *(const LAS bf16x8*)(kp + 32 * 72), k2 = *(const LAS bf16x8*)(kp + 64 * 72), k3 = *(const LAS bf16x8*)(kp + 96 * 72);
        a0 = __builtin_amdgcn_mfma_f32_32x32x16_bf16(k0, qr[d0], a0, 0, 0, 0); a1 = __builtin_amdgcn_mfma_f32_32x32x16_bf16(k1, qr[d0], a1, 0, 0, 0);
        b0 = __builtin_amdgcn_mfma_f32_32x32x16_bf16(k2, qr[d0], b0, 0, 0, 0); b1 = __builtin_amdgcn_mfma_f32_32x32x16_bf16(k3, qr[d0], b1, 0, 0, 0);
    }
    attn_softmax_pv(a0, a1, Vt, wsf, lane, o0, o1, mrun, lrun);
    attn_softmax_pv(b0, b1, Vt + 64 * 72, wsf, lane, o0, o1, mrun, lrun);
}
__device__ __forceinline__ void attn_unit(const Args& a, LAS unsigned char* lds, const bool modeB, int bh, int wave) {
    const int lane = lane_id_fresh(), tid = wave * 64 + lane;
    unsigned char* ws = a.ws;
    const int b = bh >> 3, h = bh & 7, r32 = lane & 31, hi = lane >> 5;
    const size_t hb = (size_t)(b * 8 + h) * 2048 * 64; const bf16_t* base = (const bf16_t*)(ws + WS_QKVP) + (modeB ? 3 : 0) * PSTRIDE;
    const bf16_t* Q = base + hb; const bf16_t* K = base + PSTRIDE + hb; const bf16_t* V = base + 2 * PSTRIDE + hb;
    const size_t orow0 = (size_t)b * 2048;
    const int colbase = (modeB ? 512 : 0) + h * 64;
    LAS bf16_t* Ks = (LAS bf16_t*)(lds + A_KS); LAS bf16_t* Vs = (LAS bf16_t*)(lds + A_VS);
    LAS float* tab = (LAS float*)(lds + A_TAB); LAS float* wsf = (LAS float*)(lds + A_WSF) + wave * 64; LAS float* scanw = (LAS float*)(lds + A_SCAN); LAS u32x2* tsp = (LAS u32x2*)(lds + A_TSP);
    __syncthreads();
    if (modeB) {
        const int k0 = tid * 4;
        const float* lf0 = a.out + O_LF_P + (size_t)b * 2048 * 8 + h;
        float v0 = lf0[(size_t)k0 * 8], v1 = lf0[(size_t)(k0 + 1) * 8], v2 = lf0[(size_t)(k0 + 2) * 8], v3 = lf0[(size_t)(k0 + 3) * 8];
        const float loc = (v0 + v1) + (v2 + v3);
        float inc = loc;
#pragma unroll
        for (int o = 1; o < 64; o <<= 1) { const float y = __int_as_float(__builtin_amdgcn_ds_bpermute(((lane - o) & 63) << 2, __float_as_int(inc))); if (lane >= o) inc += y; }
        if (lane == 63) scanw[wave] = inc;
        __syncthreads();
        float run = inc - loc;
        for (int w = 0; w < wave; ++w) run += scanw[w];
        float tv[4]; run += v0; tv[0] = -run * LOG2E; run += v1; tv[1] = -run * LOG2E; run += v2; tv[2] = -run * LOG2E; run += v3; tv[3] = -run * LOG2E;
#pragma unroll
        for (int i = 0; i < 4; ++i) { tab[k0 + i] = tv[i]; unsigned hh, mm, ll; split3(tv[i], hh, mm, ll); tsp[k0 + i] = (u32x2){hh | (mm << 16), ll | 0x3F800000u}; }
    } else {
        for (int i = tid; i < 257; i += 512) tab[i] = a.in[16][h * 257 + i] * LOG2E;
    }
    __syncthreads();
    const float bqk = qk_bound(ws, modeB, lane);
    const int srow = tid >> 3, sch = tid & 7;
    for (int qb = 0; qb < 8; ++qb) {
        const int q0 = qb * 256, qw = q0 + 32 * wave;
        int tlo, thi, blo, bhi;
        if (modeB) { tlo = 0; thi = (qw + 31) >> 6; blo = 0; bhi = (q0 + 255) >> 6; }
        else { const int c = qw >> 6; tlo = c > 8 ? c - 8 : 0; thi = c; const int c0 = q0 >> 6; blo = c0 > 8 ? c0 - 8 : 0; bhi = (q0 + 224) >> 6; }
        const int Tlo = blo >> 1, Thi = bhi >> 1;
        bf16x8 qr[4];
#pragma unroll
        for (int d0 = 0; d0 < 4; ++d0) qr[d0] = *(const bf16x8*)(Q + (size_t)(qw + r32) * 64 + d0 * 16 + hi * 8);
        float mrun = (modeB ? tab[qw + r32] : 0.f) + bqk, lrun = 0.f; f32x16 o0 = {}, o1 = {};
        bf16x8 bq;
        { unsigned hh, mm, ll; split3(-mrun, hh, mm, ll);
          const u32x4 w = hi == 0 ? (u32x4){0x3F803F80u, 0x3F80u | (hh << 16), mm | (ll << 16), 0u} : (u32x4){0u, 0u, 0u, 0u}; bq = __builtin_bit_cast(bf16x8, w); }
        u32x4 kr0, kr1, vr0, vr1;
        { const size_t ro = (size_t)(128 * Tlo + srow) * 64 + sch * 8;
          kr0 = *(const u32x4*)(K + ro); kr1 = *(const u32x4*)(K + ro + 64 * 64); vr0 = *(const u32x4*)(V + ro); vr1 = *(const u32x4*)(V + ro + 64 * 64); }
        *(LAS u32x4*)(Ks + srow * 72 + sch * 8) = kr0; *(LAS u32x4*)(Ks + (64 + srow) * 72 + sch * 8) = kr1;
        *(LAS u32x4*)(Vs + srow * 72 + sch * 8) = vr0; *(LAS u32x4*)(Vs + (64 + srow) * 72 + sch * 8) = vr1;
        __syncthreads();
        for (int T = Tlo; T <= Thi; ++T) {
            const int cur = (T - Tlo) & 1;
            if (T < Thi) { const size_t ro = (size_t)(128 * (T + 1) + srow) * 64 + sch * 8;
                kr0 = *(const u32x4*)(K + ro); kr1 = *(const u32x4*)(K + ro + 64 * 64); vr0 = *(const u32x4*)(V + ro); vr1 = *(const u32x4*)(V + ro + 64 * 64); }
            const LAS bf16_t* Kt = Ks + cur * KVT; const LAS bf16_t* Vt = Vs + cur * KVT;
            if (2 * T >= tlo && 2 * T <= thi) attn_tile(Kt, Vt, qr, tab, wsf, modeB, 128 * T, qw, lane, o0, o1, mrun, lrun, bq, tsp);
            if (2 * T + 1 >= tlo && 2 * T + 1 <= thi) attn_tile(Kt + 64 * 72, Vt + 64 * 72, qr, tab, wsf, modeB, 128 * T + 64, qw, lane, o0, o1, mrun, lrun, bq, tsp);
            if (T < Thi) { LAS bf16_t* Kn = Ks + (cur ^ 1) * KVT; LAS bf16_t* Vn = Vs + (cur ^ 1) * KVT;
                *(LAS u32x4*)(Kn + srow * 72 + sch * 8) = kr0; *(LAS u32x4*)(Kn + (64 + srow) * 72 + sch * 8) = kr1;
                *(LAS u32x4*)(Vn + srow * 72 + sch * 8) = vr0; *(LAS u32x4*)(Vn + (64 + srow) * 72 + sch * 8) = vr1; }
            __syncthreads();
        }
        {
            float lt; { const auto rr_ = __builtin_amdgcn_permlane32_swap(__float_as_uint(lrun), __float_as_uint(lrun), false, false); lt = __uint_as_float(rr_[0]) + __uint_as_float(rr_[1]); }
            if (hi == 0) wsf[r32] = fast_rcp(lt);
            asm volatile("s_waitcnt lgkmcnt(0)" ::: "memory");
            bf16_t* Ob = (bf16_t*)(ws + WS_O) + (orow0 + qw) * 1024 + colbase + r32;
#pragma unroll
            for (int r = 0; r < 16; ++r) { const int rr = crow(r, hi); const float f = wsf[rr];
                Ob[(size_t)rr * 1024] = (bf16_t)(cvt_pk_bf16(o0[r] * f, 0.f) & 0xffffu); Ob[(size_t)rr * 1024 + 32] = (bf16_t)(cvt_pk_bf16(o1[r] * f, 0.f) & 0xffffu); }
        }
    }
}

constexpr int A2_KV = 0, A2_TAB = 73728, A2_WSF = 76032;
__device__ __forceinline__ void attn_unit_A2(const Args& a, LAS unsigned char* lds, int u, int wave) {
    const int lane = lane_id_fresh(), tid = wave * 64 + lane;
    unsigned char* ws = a.ws;
    const int part = u & 1, bhp = u >> 1, b = bhp >> 2, g = wave >> 2, h = 2 * (bhp & 3) + g, wg = wave & 3, r32 = lane & 31, hi = lane >> 5;
    const size_t hb = (size_t)(b * 8 + h) * 2048 * 64; const bf16_t* base = (const bf16_t*)(ws + WS_QKVP);
    const bf16_t* Q = base + hb; const bf16_t* K = base + PSTRIDE + hb; const bf16_t* V = base + 2 * PSTRIDE + hb;
    const size_t orow0 = (size_t)b * 2048; const int colbase = h * 64;
    LAS bf16_t* Kg = (LAS bf16_t*)(lds + A2_KV + g * 36864); LAS bf16_t* Vg = Kg + 2 * 4608;
    LAS float* tab = (LAS float*)(lds + A2_TAB) + g * 288; LAS float* wsf = (LAS float*)(lds + A2_WSF) + wave * 64;
    __syncthreads();
    {
        const int gt = tid & 255;
        const float off = qk_bound(ws, false, lane) + *(volatile const float*)((const float*)(ws + WS_GAINS) + 264 + h) * LOG2E;
        tab[gt] = a.in[16][h * 257 + gt] * LOG2E - off; if (gt == 0) tab[256] = a.in[16][h * 257 + 256] * LOG2E - off;
    }
    __syncthreads();
    const int gt = tid & 255, srow = gt >> 2, sc = (gt & 3) * 16;
    for (int qb = part; qb < 16; qb += 2) {
        const int q0 = qb * 128, qw = q0 + 32 * wg, c = qw >> 6;
        const int tlo = c > 8 ? c - 8 : 0, thi = c, blo = 2 * qb > 8 ? 2 * qb - 8 : 0, bhi = 2 * qb + 1;
        bf16x8 qr[4];
#pragma unroll
        for (int d0 = 0; d0 < 4; ++d0) qr[d0] = *(const bf16x8*)(Q + (size_t)(qw + r32) * 64 + d0 * 16 + hi * 8);
        float mrun = 0.f, lrun = 0.f; f32x16 o0 = {}, o1 = {};
        u32x4 kr0, kr1, vr0, vr1;
        { const size_t ro = (size_t)(64 * blo + srow) * 64 + sc;
          kr0 = *(const u32x4*)(K + ro); kr1 = *(const u32x4*)(K + ro + 8); vr0 = *(const u32x4*)(V + ro); vr1 = *(const u32x4*)(V + ro + 8); }
        *(LAS u32x4*)(Kg + srow * 72 + sc) = kr0; *(LAS u32x4*)(Kg + srow * 72 + sc + 8) = kr1;
        *(LAS u32x4*)(Vg + srow * 72 + sc) = vr0; *(LAS u32x4*)(Vg + srow * 72 + sc + 8) = vr1;
        __syncthreads();
        for (int t = blo; t <= bhi; ++t) {
            const int cur = (t - blo) & 1;
            if (t < bhi) { const size_t ro = (size_t)(64 * (t + 1) + srow) * 64 + sc;
                kr0 = *(const u32x4*)(K + ro); kr1 = *(const u32x4*)(K + ro + 8); vr0 = *(const u32x4*)(V + ro); vr1 = *(const u32x4*)(V + ro + 8); }
            if (t >= tlo && t <= thi) attn_tile(Kg + cur * 4608, Vg + cur * 4608, qr, tab, wsf, false, 64 * t, qw, lane, o0, o1, mrun, lrun);
            if (t < bhi) { LAS bf16_t* Kn = Kg + (cur ^ 1) * 4608; LAS bf16_t* Vn = Vg + (cur ^ 1) * 4608;
                *(LAS u32x4*)(Kn + srow * 72 + sc) = kr0; *(LAS u32x4*)(Kn + srow * 72 + sc + 8) = kr1;
                *(LAS u32x4*)(Vn + srow * 72 + sc) = vr0; *(LAS u32x4*)(Vn + srow * 72 + sc + 8) = vr1; }
            __syncthreads();
        }
        {
            float lt; { const auto rr_ = __builtin_amdgcn_permlane32_swap(__float_as_uint(lrun), __float_as_uint(lrun), false, false); lt = __uint_as_float(rr_[0]) + __uint_as_float(rr_[1]); }
            if (hi == 0) wsf[r32] = fast_rcp(lt);
            asm volatile("s_waitcnt lgkmcnt(0)" ::: "memory");
            bf16_t* Ob = (bf16_t*)(ws + WS_O) + (orow0 + qw) * 1024 + colbase + r32;
#pragma unroll
            for (int r = 0; r < 16; ++r) { const int rr = crow(r, hi); const float f = wsf[rr];
                Ob[(size_t)rr * 1024] = (bf16_t)(cvt_pk_bf16(o0[r] * f, 0.f) & 0xffffu); Ob[(size_t)rr * 1024 + 32] = (bf16_t)(cvt_pk_bf16(o1[r] * f, 0.f) & 0xffffu); }
        }
    }
}

constexpr int S_KV = 0, S_TAB = 73728, S_WSF = 90368, S_SCAN = 92416;
__device__ __forceinline__ void samp_tile(const LAS bf16_t* Kw, const bf16x8 (&qr)[4], const LAS bf16_t* Vw, const LAS float* tab, LAS float* wsf, const bool modeB, const bool isnew, const int t0,
                                          const int lane, f32x16& o0, f32x16& o1, float& mrun, float& lrun) {
    const int r32 = lane & 31, hi = lane >> 5;
    f32x16 p = {};
#pragma unroll
    for (int d0 = 0; d0 < 4; ++d0) { const bf16x8 kf = *(const LAS bf16x8*)(Kw + r32 * 72 + d0 * 16 + hi * 8); p = __builtin_amdgcn_mfma_f32_32x32x16_bf16(kf, qr[d0], p, 0, 0, 0); }
    if (modeB) {
#pragma unroll
        for (int rg = 0; rg < 4; ++rg) { const f32x4 c0 = *(const LAS f32x4*)(tab + t0 + 8 * rg + 4 * hi);
#pragma unroll
            for (int i = 0; i < 4; ++i) p[4 * rg + i] += c0[i]; }
        if (isnew) {
#pragma unroll
            for (int r = 0; r < 16; ++r) if (crow(r, hi) > r32) p[r] = NEGB; }
    } else {
        if (512 - (t0 + 31) >= 128) { const float c = tab[256];
#pragma unroll
            for (int r = 0; r < 16; ++r) p[r] += c; }
        else {
#pragma unroll
            for (int r = 0; r < 16; ++r) { const int rel = 512 + r32 - (t0 + crow(r, hi)); int i0 = rel < -128 ? -128 : rel; i0 = i0 > 128 ? 128 : i0; p[r] += tab[i0 + 128]; } }
    }
    float sum = 0.f;
#pragma unroll
    for (int r = 0; r < 16; ++r) { p[r] = fast_exp2(p[r] - mrun); sum += p[r]; }
    lrun += sum;
    bf16x8 pa[2];
    pa[0] = pack8(p[0], p[1], p[2], p[3], p[4], p[5], p[6], p[7]); pa[1] = pack8(p[8], p[9], p[10], p[11], p[12], p[13], p[14], p[15]);
    const LAS bf16_t* vb = Vw + (4 * hi + ((lane & 15) >> 2)) * 72 + 16 * ((lane >> 4) & 1) + 4 * (lane & 3);
#pragma unroll
    for (int g = 0; g < 2; ++g) {
#pragma unroll
        for (int d0 = 0; d0 < 2; ++d0) {
            const v4i16_t lo = __builtin_amdgcn_ds_read_tr16_b64_v4i16((LAS v4i16_t*)(vb + (16 * g) * 72 + 32 * d0));
            const v4i16_t up = __builtin_amdgcn_ds_read_tr16_b64_v4i16((LAS v4i16_t*)(vb + (16 * g + 8) * 72 + 32 * d0));
            const bf16x8 vf = (bf16x8){lo[0], lo[1], lo[2], lo[3], up[0], up[1], up[2], up[3]};
            if (d0 == 0) o0 = __builtin_amdgcn_mfma_f32_32x32x16_bf16(pa[g], vf, o0, 0, 0, 0);
            else         o1 = __builtin_amdgcn_mfma_f32_32x32x16_bf16(pa[g], vf, o1, 0, 0, 0);
        }
    }
}
__device__ __forceinline__ void samp_unit(const Args& a, LAS unsigned char* lds, const bool modeB, int bh, int wave) {
    const int lane = lane_id_fresh(), tid = wave * 64 + lane;
    unsigned char* ws = a.ws;
    const int b = bh >> 3, h = bh & 7, r32 = lane & 31, hi = lane >> 5;
    const int P = modeB ? 4096 : 512, ttot = P + 32;
    const float* Kc = a.in[modeB ? 4 : 2] + (size_t)b * P * 512 + h * 64;
    const float* Vc = a.in[modeB ? 5 : 3] + (size_t)b * P * 512 + h * 64;
    const bf16_t* Qn = (const bf16_t*)(ws + (modeB ? WS_QBS : WS_QAS)) + (size_t)(b * 8 + h) * 2048;
    const bf16_t* Kn = (const bf16_t*)(ws + (modeB ? WS_KBN : WS_KAN)) + (size_t)(b * 8 + h) * 2048;
    const bf16_t* Vn = (const bf16_t*)(ws + (modeB ? WS_VBN : WS_VAN)) + (size_t)(b * 8 + h) * 2048;
    LAS bf16_t* Kw = (LAS bf16_t*)(lds + S_KV) + wave * 4608; LAS bf16_t* Vw = Kw + 2304;
    LAS float* tab = (LAS float*)(lds + S_TAB); LAS float* wsf = (LAS float*)(lds + S_WSF) + wave * 64; LAS float* scanw = (LAS float*)(lds + S_SCAN);
    __syncthreads();
    if (modeB) {
        const int per = (ttot + 511) >> 9, k0 = tid * per;
        const float* lf0 = a.in[6] + (size_t)b * 4096 * 8 + h; const float* lf1 = a.out + O_LF_S + (size_t)b * 32 * 8 + h;
        float loc = 0.f;
        for (int i = 0; i < per; ++i) { const int k = k0 + i; if (k < ttot) loc += (k < P) ? lf0[(size_t)k * 8] : lf1[(size_t)(k - P) * 8]; }
        float inc = loc;
#pragma unroll
        for (int o = 1; o < 64; o <<= 1) { const float y = __int_as_float(__builtin_amdgcn_ds_bpermute(((lane - o) & 63) << 2, __float_as_int(inc))); if (lane >= o) inc += y; }
        if (lane == 63) scanw[wave] = inc;
        __syncthreads();
        float run = inc - loc;
        for (int w = 0; w < wave; ++w) run += scanw[w];
        for (int i = 0; i < per; ++i) { const int k = k0 + i; if (k < ttot) { run += (k < P) ? lf0[(size_t)k * 8] : lf1[(size_t)(k - P) * 8]; tab[k] = -run * LOG2E; } }
    } else {
        const float off = qk_bound(ws, false, lane) + *(volatile const float*)((const float*)(ws + WS_GAINS) + 264 + h) * LOG2E;
        for (int i = tid; i < 257; i += 512) tab[i] = a.in[16][h * 257 + i] * LOG2E - off;
    }
    __syncthreads();
    bf16x8 qr[4];
#pragma unroll
    for (int d0 = 0; d0 < 4; ++d0) qr[d0] = *(const bf16x8*)(Qn + r32 * 64 + d0 * 16 + hi * 8);
    float mrun = modeB ? tab[P + r32] + qk_bound(ws, true, lane) : 0.f, lrun = 0.f; f32x16 o0 = {}, o1 = {};
    const int ntile = P >> 5;
    f32x4 rk[8], rv[8];
    const size_t lo_off = (size_t)(lane >> 4) * 512 + 4 * (lane & 15);
    const int lw = (lane >> 4) * 72 + 4 * (lane & 15);
    int t = wave;
    {
#pragma unroll
        for (int j = 0; j < 8; ++j) { rk[j] = __builtin_nontemporal_load((const f32x4*)(Kc + (size_t)t * 16384 + lo_off + (size_t)j * 2048)); rv[j] = __builtin_nontemporal_load((const f32x4*)(Vc + (size_t)t * 16384 + lo_off + (size_t)j * 2048)); }
    }
    for (; t < ntile; t += 8) {
#pragma unroll
        for (int j = 0; j < 8; ++j) { u32x2 wk, wv; wk.x = cvt_pk_bf16(rk[j][0], rk[j][1]); wk.y = cvt_pk_bf16(rk[j][2], rk[j][3]); wv.x = cvt_pk_bf16(rv[j][0], rv[j][1]); wv.y = cvt_pk_bf16(rv[j][2], rv[j][3]);
            *(LAS u32x2*)(Kw + lw + j * 288) = wk; *(LAS u32x2*)(Vw + lw + j * 288) = wv; }
        if (t + 8 < ntile) {
#pragma unroll
            for (int j = 0; j < 8; ++j) { rk[j] = __builtin_nontemporal_load((const f32x4*)(Kc + (size_t)(t + 8) * 16384 + lo_off + (size_t)j * 2048)); rv[j] = __builtin_nontemporal_load((const f32x4*)(Vc + (size_t)(t + 8) * 16384 + lo_off + (size_t)j * 2048)); }
        }
        samp_tile(Kw, qr, Vw, tab, wsf, modeB, false, 32 * t, lane, o0, o1, mrun, lrun);
    }
    if (wave == 0) {
#pragma unroll
        for (int j = 0; j < 4; ++j) { const int row = (lane >> 3) + 8 * j, col = 8 * (lane & 7);
            *(LAS bf16x8*)(Kw + row * 72 + col) = *(const bf16x8*)(Kn + row * 64 + col); *(LAS bf16x8*)(Vw + row * 72 + col) = *(const bf16x8*)(Vn + row * 64 + col); }
        samp_tile(Kw, qr, Vw, tab, wsf, modeB, true, P, lane, o0, o1, mrun, lrun);
    }
    {
        float lt; { const auto rr_ = __builtin_amdgcn_permlane32_swap(__float_as_uint(lrun), __float_as_uint(lrun), false, false); lt = __uint_as_float(rr_[0]) + __uint_as_float(rr_[1]); }
        LAS float* oc = (LAS float*)(lds + S_KV + wave * 9216); LAS float* ml = oc + 2048;
#pragma unroll
        for (int r = 0; r < 16; ++r) { oc[crow(r, hi) * 64 + r32] = o0[r]; oc[crow(r, hi) * 64 + 32 + r32] = o1[r]; }
        if (hi == 0) { ml[2 * r32] = mrun; ml[2 * r32 + 1] = lt; }
    }
    __syncthreads();
    {
        const int q = tid >> 4, d4 = (tid & 15) * 4;
        const LAS float* mlb = (const LAS float*)(lds + S_KV) + 2048 + 2 * q; const LAS float* ocb = (const LAS float*)(lds + S_KV) + q * 64 + d4;
        float M = mlb[0];
#pragma unroll
        for (int w = 1; w < 8; ++w) M = fmaxf(M, mlb[w * 2304]);
        f32x4 num = {0.f, 0.f, 0.f, 0.f}; float den = 0.f;
#pragma unroll
        for (int w = 0; w < 8; ++w) { const float f = fast_exp2(mlb[w * 2304] - M); den += f * mlb[w * 2304 + 1]; num += *(const LAS f32x4*)(ocb + w * 2304) * f; }
        const float inv = 1.0f / den;
        u32x2 w2; w2.x = cvt_pk_bf16(num[0] * inv, num[1] * inv); w2.y = cvt_pk_bf16(num[2] * inv, num[3] * inv);
        *(u32x2*)((bf16_t*)(ws + WS_O) + ((size_t)MP + b * 32 + q) * 1024 + (modeB ? 512 : 0) + h * 64 + d4) = w2;
    }
}

#define XB_TMO      128
#define XB_XCNT(j)  (256  + 64 * (j))
#define XB_XSUB(j)  (1280 + 64 * (j))
#define XB_XGEN(j)  (2304 + 64 * (j))
#define XB_TOP      3328
#define XB_TOPGEN   3392
#define XB_SPIN_CAP (1u << 20)
__device__ __forceinline__ unsigned xb_ld(unsigned* p)              { return __hip_atomic_load(p, __ATOMIC_RELAXED, __HIP_MEMORY_SCOPE_AGENT); }
__device__ __forceinline__ unsigned xb_add(unsigned* p, unsigned v) { return __hip_atomic_fetch_add(p, v, __ATOMIC_RELAXED, __HIP_MEMORY_SCOPE_AGENT); }
__device__ __forceinline__ unsigned xb_xcc_id() { return (unsigned)__builtin_amdgcn_s_getreg((3 << 11) | 20) & 0xFu; }
#define XB_SPIN(cond, bar) do { unsigned _sp = 0; while (cond) { __builtin_amdgcn_s_sleep(1); \
    if ((++_sp & 255u) == 0u) { if (xb_ld(&(bar)[XB_TMO])) break; if (_sp > XB_SPIN_CAP) { atomicAdd(&(bar)[XB_TMO], 1u); break; } } } } while (0)
__device__ __forceinline__ void xcd_barrier_complete(unsigned* bar, unsigned x, unsigned G, unsigned& nloc, unsigned& nx) {
    unsigned sum, cnt, mine, sp = 0u;
    for (;;) {
        sum = 0u; cnt = 0u; mine = 0u;
#pragma unroll
        for (unsigned j = 0; j < 16; ++j) { const unsigned c = xb_ld(&bar[XB_XCNT(j)]); sum += c; cnt += (c > 0u) ? 1u : 0u; mine = (j == x) ? c : mine; }
        if (sum == G) break;
        __builtin_amdgcn_s_sleep(1);
        if ((++sp & 255u) == 0u) { if (xb_ld(&bar[XB_TMO])) break; if (sp > XB_SPIN_CAP) { atomicAdd(&bar[XB_TMO], 1u); break; } }
    }
    nloc = mine > 0u ? mine : 1u; nx = cnt > 0u ? cnt : 1u;
}
__device__ __forceinline__ void grid_bar(unsigned* bar, volatile LAS unsigned* st, unsigned x, unsigned G, int wave) {
    asm volatile("s_waitcnt vmcnt(0)" ::: "memory");
    __syncthreads();
    if (wave == 0 && lane_id_fresh() == 0) {
        __builtin_amdgcn_s_waitcnt(0);
        unsigned nloc = st[0], nx = st[1];
        if (nloc == 0u) { xcd_barrier_complete(bar, x, G, nloc, nx); st[0] = nloc; st[1] = nx; }
        const unsigned old = xb_add(&bar[XB_XSUB(x)], 1u);
        const unsigned gen = old / nloc;
        if (old + 1u == (gen + 1u) * nloc) {
            __builtin_amdgcn_fence(__ATOMIC_RELEASE, "agent");
            asm volatile("s_waitcnt vmcnt(0)" ::: "memory");
            const unsigned og = xb_add(&bar[XB_TOP], 1u);
            const unsigned tg = og / nx;
            if (og + 1u == (tg + 1u) * nx) xb_add(&bar[XB_TOPGEN], 1u);
            else XB_SPIN(xb_ld(&bar[XB_TOPGEN]) == tg, bar);
            __builtin_amdgcn_fence(__ATOMIC_ACQUIRE, "agent");
            xb_add(&bar[XB_XGEN(x)], 1u);
            asm volatile("s_waitcnt vmcnt(0)" ::: "memory");
        } else {
            XB_SPIN(xb_ld(&bar[XB_XGEN(x)]) == gen, bar);
            __builtin_amdgcn_fence(__ATOMIC_ACQUIRE, "agent");
            asm volatile("s_waitcnt vmcnt(0)" ::: "memory");
        }
    }
    __syncthreads();
}

__global__ void __launch_bounds__(512, 2) mk_fwd(Args a) {
    extern __shared__ __attribute__((aligned(16))) unsigned char lds_raw[];
    LAS unsigned char* lds = (LAS unsigned char*)lds_raw;
    const int wave = __builtin_amdgcn_readfirstlane((int)threadIdx.x >> 6);
    unsigned char* ws = a.ws;
    const int lo = a.ph_lo, hi = a.ph_hi, G = gridDim.x, c = blockIdx.x;
#if MK_N_LAUNCHES == 1
    if (lo < 0) cg::this_grid().sync();
    volatile LAS unsigned* xb_st = (volatile LAS unsigned*)(lds + (LDS_BYTES - 16));
    const unsigned xb_x = xb_xcc_id();
    if (wave == 0 && lane_id_fresh() == 0) { xb_st[0] = 0u; xb_st[1] = 0u; (void)xb_add(&((unsigned*)ws)[XB_XCNT(xb_x)], 1u); }
    __syncthreads();
#define SEAM(k) do { if (lo <= (k) && (k) + 1 < hi) grid_bar((unsigned*)ws, xb_st, xb_x, (unsigned)G, wave); } while (0)
#else
#define SEAM(k) do { } while (0)
#endif
#define IN(k) (lo <= (k) && (k) < hi)
    if (IN(0)) { phase0(a, lds, wave); SEAM(0); }
    if (IN(1)) {
        pg8::Gemm g{(const bf16_t*)(ws + WS_XB), (const bf16_t*)(ws + WS_WQKV), MT, NQKV, 1024}; pg8::StaticOrder S; S.init(MT, NQKV, G, c);
        EpiQKV E{(const float*)(ws + WS_RSTD0), (const float*)(ws + WS_GAINS), ws, a.out};
        pg8::gemm_phase<EpiQKV, pg8::StaticOrder, true, true>(lds, g, S, E, wave);
        { int rk_, cn_; shadow_share((MT / 256) * (NQKV / 256), G, c, rk_, cn_); if (cn_ > 0) tr_set(a, lds, wave, lane_id_fresh(), 1, rk_ * 8 + wave, cn_ * 8); }
        SEAM(1);
    }
    if (IN(2)) {
        for (int i = 0; i < 4; ++i) { const int ty = (c & 1) ? ((i + 2) & 3) : i;
            for (int bh0 = c; bh0 < 256; bh0 += G) { int bh = bh0; asm volatile("" : "+s"(bh));
                if (ty == 0) { int one = 1; asm volatile("" : "+s"(one)); attn_unit(a, lds, one != 0, bh, wave); } else if (ty == 1) attn_unit_A2(a, lds, bh, wave); else samp_unit(a, lds, ty == 2, bh, wave); } }
        SEAM(2);
    }
    if (IN(3)) {
        { pg8::Gemm g{(const bf16_t*)(ws + WS_O), (const bf16_t*)(ws + WS_WO), MT, 1024, 1024}; pg8::StaticOrder S; S.init(MT, 1024, G, c);
          EpiRes<false> E{nullptr, nullptr, (bf16_t*)(ws + WS_XB), (float*)(ws + WS_SSQ1)};
          pg8::gemm_phase<EpiRes<false>, pg8::StaticOrder, true, true>(lds, g, S, E, wave); }
        { int rk_, cn_; shadow_share((MT / 256) * 4, G, c, rk_, cn_); if (cn_ > 0) p_convert(a, (size_t)rk_ * 512 + wave * 64 + lane_id_fresh(), (size_t)cn_ * 512); }
        SEAM(3);
    }
    if (IN(4)) {
        pg8::Gemm g{(const bf16_t*)(ws + WS_XB), (const bf16_t*)(ws + WS_WGU), MT, 2 * DFF, 1024}; pg8::StaticOrder S; S.init(MT, 2 * DFF, G, c);
        EpiSwiGLU E{(const float*)(ws + WS_SSQ1), (bf16_t*)(ws + WS_H)};
        pg8::gemm_phase<EpiSwiGLU, pg8::StaticOrder, true, true>(lds, g, S, E, wave);
        { int rk_, cn_; shadow_share((MT / 256) * (2 * DFF / 256), G, c, rk_, cn_); if (cn_ > 0) tr_set(a, lds, wave, lane_id_fresh(), 2, rk_ * 8 + wave, cn_ * 8); }
        SEAM(4);
    }
    if (IN(5)) {
        pg8::Gemm g{(const bf16_t*)(ws + WS_H), (const bf16_t*)(ws + WS_WD), MT, 1024, DFF}; pg8::StaticOrder S; S.init(MT, 1024, G, c);
        EpiRes<false> E{nullptr, nullptr, (bf16_t*)(ws + WS_XB), (float*)(ws + WS_SSQ2)};
        pg8::gemm_phase<EpiRes<false>, pg8::StaticOrder, true, true>(lds, g, S, E, wave);
        {
            const int nu = (MT / 256) * 4, tailc = nu - (nu / G) * G;
            const bool split = tailc > 0 && tailc * 2 < G;
            if (!split || c >= tailc) {
                pg8::Gemm g2{(const bf16_t*)(ws + WS_PB), (const bf16_t*)(ws + WS_WPP), MT, 1024, PLE}; pg8::StaticOrder S2; S2.init(MT, 1024, split ? G - tailc : G, split ? c - tailc : c);
                EpiStore E2{(bf16_t*)(ws + WS_PP), 1024};
                pg8::gemm_phase<EpiStore, pg8::StaticOrder, true, true>(lds, g2, S2, E2, wave);
            }
        }
        SEAM(5);
    }
    if (IN(6)) {
        pg8::Gemm g{(const bf16_t*)(ws + WS_XB), (const bf16_t*)(ws + WS_WPG), MT, 1024, 1024}; pg8::StaticOrder S; S.init(MT, 1024, G, c);
        EpiPle E{(const float*)(ws + WS_SSQ2), (const bf16_t*)(ws + WS_PP), (const bf16_t*)(ws + WS_XB), a.out + O_Y};
        pg8::gemm_phase<EpiPle, pg8::StaticOrder, true, true>(lds, g, S, E, wave);
    }
#undef IN
#undef SEAM
}

extern "C" void kernel_launch(void* const* d_in, const int* in_sizes, int n_in, void* d_out, int out_size, void* d_ws, size_t ws_size, hipStream_t stream) {
    static int grid = 0;
    if (grid == 0) {
        if (n_in != 25 || (size_t)out_size != O_END || ws_size < WS_END) { fprintf(stderr, "kernel_launch: unexpected shapes: n_in %d out %d (want %zu) ws %zu (want >= %zu)\n", n_in, out_size, (size_t)O_END, ws_size, (size_t)WS_END); if (n_in != 25 || ws_size < WS_END) { grid = -1; return; } }
        int dev = 0, cus = 0, per_cu = 0;
        if (hipGetDevice(&dev) != hipSuccess || hipDeviceGetAttribute(&cus, hipDeviceAttributeMultiprocessorCount, dev) != hipSuccess) { grid = -1; return; }
        if (hipFuncSetAttribute((const void*)mk_fwd, hipFuncAttributeMaxDynamicSharedMemorySize, LDS_BYTES) != hipSuccess) { fprintf(stderr, "kernel_launch: hipFuncSetAttribute failed\n"); grid = -1; return; }
        if (hipOccupancyMaxActiveBlocksPerMultiprocessor(&per_cu, (const void*)mk_fwd, 512, LDS_BYTES) != hipSuccess || per_cu < 1) { fprintf(stderr, "kernel_launch: occupancy query says %d\n", per_cu); per_cu = 1; }
        (void)hipGetLastError();
        grid = cus * per_cu;
    }
    if (grid < 0) return;
    Args a{};
    for (int i = 0; i < 25; ++i) a.in[i] = (const float*)d_in[i];
    a.out = (float*)d_out; a.ws = (unsigned char*)d_ws;
#if MK_N_LAUNCHES == 1
    a.ph_lo = 0; a.ph_hi = 7;
    if (hipMemsetAsync(d_ws, 0, 16384, stream) != hipSuccess) { fprintf(stderr, "kernel_launch: memset failed\n"); return; }
    void* args[] = {&a};
    hipError_t e = hipLaunchCooperativeKernel((const void*)mk_fwd, dim3(grid), dim3(512), args, LDS_BYTES, stream);
    if (e != hipSuccess) fprintf(stderr, "kernel_launch: cooperative launch failed: %s (grid %d)\n", hipGetErrorString(e), grid);
#else
    for (int ph = 0; ph < 7; ++ph) { a.ph_lo = ph; a.ph_hi = ph + 1; hipLaunchKernelGGL(mk_fwd, dim3(grid), dim3(512), LDS_BYTES, stream, a); }
#endif
}
```

```cpp
#include <hip/hip_runtime.h>
#include <hip/hip_cooperative_groups.h>
#include <cstdio>
#include <cstdint>
namespace cg = cooperative_groups;
#ifndef MK_N_LAUNCHES
#define MK_N_LAUNCHES 1
#endif
namespace pg8 {
#define PG8_LAS __attribute__((address_space(3)))
typedef unsigned short bf16_t;
typedef short bf16x8 __attribute__((ext_vector_type(8)));
typedef float f32x4 __attribute__((ext_vector_type(4)));
typedef unsigned u32x4 __attribute__((ext_vector_type(4)));
constexpr int BM = 256, BK = 64, HALF = 128, HTB = HALF * BK * 2  , STAGE_BYTES = 8 * HTB, NXCD = 8, WGM = 8;

__host__ __device__ __forceinline__ int lds_byte(int r, int c) { const int st = (r >> 4) * 2 + (c >> 5), rr = r & 15, cc = c & 31, ob = rr * 64 + cc * 2; return st * 1024 + (ob ^ (((ob >> 9) & 1) << 5)); }
__host__ __device__ __forceinline__ void stage_rc(int b, int& R, int& C) { const int st = b / 1024, sb = b % 1024, swz = sb ^ (((sb >> 9) & 1) << 5); R = (st >> 1) * 16 + swz / 64; C = (st & 1) * 32 + (swz % 64) / 2; }
__host__ __device__ __forceinline__ int perm32(int rho) { const int n = rho >> 4, i = rho & 15; return 8 * (i >> 2) + 4 * n + (i & 3); }

struct Unit { int pm, pn; };
struct Gemm { const bf16_t* A; const bf16_t* Bt; int M, N, K; };

struct StaticOrder {
    int nM, nN, nwg, G, c;
    __host__ __device__ void init(int M, int N, int G_, int c_) { nM = M / BM; nN = N / BM; nwg = nM * nN; G = G_; c = c_; }
    __host__ __device__ bool next(int i, Unit& u) const {
        const long L = (long)i * G + c; if (L >= nwg) return false;
        int wgid = (int)L; { const int q = nwg / NXCD, r = nwg % NXCD, xcd = wgid % NXCD, off = wgid / NXCD; wgid = (xcd < r ? xcd * (q + 1) : r * (q + 1) + (xcd - r) * q) + off; }
        const int nig = WGM * nN, gid = wgid / nig, fm = gid * WGM, gsz = (nM - fm) < WGM ? (nM - fm) : WGM;
        u.pm = fm + ((wgid % nig) % gsz); u.pn = (wgid % nig) / gsz; return true;
    }
    __device__ __forceinline__ void a_ready(const Unit&) const {}
    __device__ __forceinline__ void done(const Unit&) const {}
};

typedef float f32x2_cv __attribute__((ext_vector_type(2))); typedef __bf16 bf16x2_cv __attribute__((ext_vector_type(2)));
__device__ __forceinline__ unsigned cvt_pk_bf16(float lo, float hi) { const f32x2_cv v = {lo, hi}; const bf16x2_cv b = __builtin_convertvector(v, bf16x2_cv); return __builtin_bit_cast(unsigned, b); }
typedef float f32x2 __attribute__((ext_vector_type(2)));
template <class Epi, class Sched, bool ALIGN_EPI = false, bool SP2 = false>
__device__ __forceinline__ void gemm_phase(PG8_LAS unsigned char* lds, const Gemm g, const Sched& S, const Epi& E, const int wid) {
    int lane_; asm volatile("v_mbcnt_lo_u32_b32 %0, -1, 0\n\tv_mbcnt_hi_u32_b32 %0, -1, %0" : "=v"(lane_));
    const int lane = lane_, tid = wid * 64 + lane, wr = wid >> 2, wc = wid & 3, fr = lane & 15, fq = lane >> 4;
    const int K = g.K, nt = K / BK;
    unsigned voffA[2], voffB[2];
#pragma unroll
    for (int i = 0; i < 2; ++i) { int R, C; stage_rc(tid * 16 + i * 8192, R, C); const int Rb = Epi::PERM ? ((R & ~31) + perm32(R & 31)) : R;
        voffA[i] = (unsigned)(R * K + C) * 2u; voffB[i] = (unsigned)(Rb * K + C) * 2u; }
    const size_t kstep = (size_t)(BK * 2);
    const size_t hstep = (size_t)HALF * K * 2;
    const size_t tstep = 2 * hstep;
    const unsigned ldsw = (unsigned)wid * 1024u;
    const int aoff = lds_byte(wr * 64 + fr, fq * 8), boff = lds_byte(wc * 32 + fr, fq * 8);
#define PG8_SA(b, h) (((b) * 2 + (h)) * HTB)
#define PG8_SB(b, h) ((4 + (b) * 2 + (h)) * HTB)
#define PG8_STAGE(bufoff, gbase, voff) do { _Pragma("unroll") for (int _i = 0; _i < 2; ++_i) \
        __builtin_amdgcn_global_load_lds((const unsigned*)((const char*)(gbase) + (voff)[_i]), (PG8_LAS unsigned*)(lds + (bufoff) + ldsw + _i * 8192), 16, 0, 0); } while (0)
#define PG8_LDA(dst, b, h) do { _Pragma("unroll") for (int m = 0; m < 4; ++m) _Pragma("unroll") for (int k = 0; k < 2; ++k) dst[m][k] = *(const PG8_LAS bf16x8*)(lds + PG8_SA(b, h) + aoff + m * 2048 + k * 1024); } while (0)
#define PG8_LDB(dst, b, h) do { _Pragma("unroll") for (int n = 0; n < 2; ++n) _Pragma("unroll") for (int k = 0; k < 2; ++k) dst[n][k] = *(const PG8_LAS bf16x8*)(lds + PG8_SB(b, h) + boff + n * 2048 + k * 1024); } while (0)
#define PG8_MMA(ai, bj, At, Bt) do { __builtin_amdgcn_s_setprio(1); _Pragma("unroll") for (int m = 0; m < 4; ++m) _Pragma("unroll") for (int n = 0; n < 2; ++n) _Pragma("unroll") for (int k = 0; k < 2; ++k) \
        acc[ai][bj][m][n] = __builtin_amdgcn_mfma_f32_16x16x32_bf16(Bt[n][k], At[m][k], acc[ai][bj][m][n], 0, 0, 0); __builtin_amdgcn_s_setprio(0); } while (0)
#define PG8_WAIT_V(n) asm volatile("s_waitcnt vmcnt(" #n ")" ::: "memory")
#define PG8_WAIT_L(n) asm volatile("s_waitcnt lgkmcnt(" #n ")" ::: "memory")
#define PG8_BAR __builtin_amdgcn_s_barrier()
#define PG8_SCHED __builtin_amdgcn_sched_barrier(0)
    Unit cur, nxt; int ui = 0;
    if (!S.next(0, cur)) return;
    f32x4 acc[2][2][4][2];
#pragma unroll
    for (int a = 0; a < 2; ++a)
#pragma unroll
        for (int b = 0; b < 2; ++b)
#pragma unroll
            for (int m = 0; m < 4; ++m)
#pragma unroll
                for (int n = 0; n < 2; ++n) acc[a][b][m][n] = (f32x4){0.f, 0.f, 0.f, 0.f};
    bf16x8 At[4][2], B0[2][2], B1[2][2];
    const char* cA = (const char*)g.A + (size_t)cur.pm * tstep; const char* cB = (const char*)g.Bt + (size_t)cur.pn * tstep;
    S.a_ready(cur);
    if constexpr (SP2) {
        PG8_STAGE(PG8_SB(0, 0), cB, voffB); PG8_STAGE(PG8_SB(0, 1), cB + hstep, voffB); PG8_STAGE(PG8_SA(0, 0), cA, voffA); PG8_STAGE(PG8_SA(0, 1), cA + hstep, voffA);
        if (wr == 1) PG8_BAR;
        PG8_WAIT_V(2); PG8_BAR;
        PG8_STAGE(PG8_SB(1, 0), cB + kstep, voffB); PG8_STAGE(PG8_SA(1, 0), cA + kstep, voffA); PG8_STAGE(PG8_SB(1, 1), cB + hstep + kstep, voffB);
        PG8_WAIT_V(6); PG8_BAR;
    } else {
        PG8_STAGE(PG8_SB(0, 0), cB, voffB); PG8_STAGE(PG8_SA(0, 0), cA, voffA); PG8_STAGE(PG8_SB(0, 1), cB + hstep, voffB); PG8_STAGE(PG8_SA(0, 1), cA + hstep, voffA);
        if (wr == 1) PG8_BAR;
        PG8_WAIT_V(4); PG8_BAR;
        PG8_STAGE(PG8_SB(1, 0), cB + kstep, voffB); PG8_STAGE(PG8_SA(1, 0), cA + kstep, voffA); PG8_STAGE(PG8_SB(1, 1), cB + hstep + kstep, voffB);
        PG8_WAIT_V(6); PG8_BAR;
    }
    for (;;) {
        const bool has_next = S.next(ui + 1, nxt);
        const char* nA = has_next ? (const char*)g.A + (size_t)nxt.pm * tstep : cA; const char* nB = has_next ? (const char*)g.Bt + (size_t)nxt.pn * tstep : cB;
        for (int t = 0; t < nt; t += 2) {
            const bool last = (t == nt - 2);
            const char* a1 = cA + (size_t)(t + 1) * kstep;
            const char* a2 = last ? nA : cA + (size_t)(t + 2) * kstep; const char* b2 = last ? nB : cB + (size_t)(t + 2) * kstep;
            const char* a3 = a2 + kstep; const char* b3 = b2 + kstep;
            if (last && has_next) S.a_ready(nxt);
            if constexpr (SP2) {
            PG8_LDB(B0, 0, 0); PG8_LDB(B1, 0, 1); PG8_SCHED; PG8_LDA(At, 0, 0); PG8_STAGE(PG8_SA(1, 1), a1 + hstep, voffA);
            PG8_WAIT_V(8); PG8_WAIT_L(0); PG8_BAR; PG8_MMA(0, 0, At, B0); PG8_MMA(0, 1, At, B1); PG8_BAR; PG8_SCHED;
            PG8_LDA(At, 0, 1); PG8_STAGE(PG8_SB(0, 0), b2, voffB); PG8_STAGE(PG8_SB(0, 1), b2 + hstep, voffB); PG8_STAGE(PG8_SA(0, 0), a2, voffA);
            PG8_WAIT_V(8); PG8_WAIT_L(0); PG8_BAR; PG8_MMA(1, 0, At, B0); PG8_MMA(1, 1, At, B1); PG8_BAR; PG8_SCHED;
            PG8_LDB(B0, 1, 0); PG8_LDB(B1, 1, 1); PG8_SCHED; PG8_LDA(At, 1, 0); PG8_STAGE(PG8_SA(0, 1), a2 + hstep, voffA);
            PG8_WAIT_V(8); PG8_WAIT_L(0); PG8_BAR; PG8_MMA(0, 0, At, B0); PG8_MMA(0, 1, At, B1); PG8_BAR; PG8_SCHED;
            PG8_LDA(At, 1, 1); PG8_STAGE(PG8_SB(1, 0), b3, voffB); PG8_STAGE(PG8_SB(1, 1), b3 + hstep, voffB); PG8_STAGE(PG8_SA(1, 0), a3, voffA);
            PG8_WAIT_V(8); PG8_WAIT_L(0); PG8_BAR; PG8_MMA(1, 0, At, B0); PG8_MMA(1, 1, At, B1); PG8_BAR; PG8_SCHED;
            } else {
            PG8_LDB(B0, 0, 0); PG8_SCHED; PG8_LDA(At, 0, 0); PG8_STAGE(PG8_SA(1, 1), a1 + hstep, voffA);
            PG8_WAIT_L(8); PG8_BAR; PG8_WAIT_L(0); PG8_MMA(0, 0, At, B0); PG8_BAR; PG8_SCHED;
            PG8_LDB(B1, 0, 1); PG8_STAGE(PG8_SB(0, 0), b2, voffB);
            PG8_BAR; PG8_WAIT_L(0); PG8_MMA(0, 1, At, B1); PG8_BAR;
            PG8_LDA(At, 0, 1); PG8_STAGE(PG8_SA(0, 0), a2, voffA);
            PG8_BAR; PG8_WAIT_L(0); PG8_MMA(1, 0, At, B0); PG8_BAR; PG8_SCHED;
            PG8_STAGE(PG8_SB(0, 1), b2 + hstep, voffB);
            PG8_WAIT_V(6); PG8_BAR; PG8_MMA(1, 1, At, B1); PG8_BAR;
            PG8_LDB(B0, 1, 0); PG8_SCHED; PG8_LDA(At, 1, 0); PG8_STAGE(PG8_SA(0, 1), a2 + hstep, voffA);
            PG8_WAIT_L(8); PG8_BAR; PG8_WAIT_L(0); PG8_MMA(0, 0, At, B0); PG8_BAR; PG8_SCHED;
            PG8_LDB(B1, 1, 1); PG8_STAGE(PG8_SB(1, 0), b3, voffB);
            PG8_BAR; PG8_WAIT_L(0); PG8_MMA(0, 1, At, B1); PG8_BAR;
            PG8_LDA(At, 1, 1); PG8_STAGE(PG8_SA(1, 0), a3, voffA);
            PG8_BAR; PG8_WAIT_L(0); PG8_MMA(1, 0, At, B0); PG8_BAR; PG8_SCHED;
            PG8_STAGE(PG8_SB(1, 1), b3 + hstep, voffB);
            PG8_WAIT_V(6); PG8_BAR; PG8_MMA(1, 1, At, B1); PG8_BAR;
            }
        }
        if constexpr (ALIGN_EPI) { if (wr == 0) PG8_BAR; }
        if constexpr (!Epi::AFTER_DRAIN) { E(acc, cur, wr, wc, fr, fq); S.done(cur); }
        if (!has_next) break;
#pragma unroll
        for (int a = 0; a < 2; ++a)
#pragma unroll
            for (int b = 0; b < 2; ++b)
#pragma unroll
                for (int m = 0; m < 4; ++m)
#pragma unroll
                    for (int n = 0; n < 2; ++n) acc[a][b][m][n] = (f32x4){0.f, 0.f, 0.f, 0.f};
        cur = nxt; cA = nA; cB = nB; ++ui;
        if constexpr (ALIGN_EPI) { if (wr == 1) PG8_BAR; }
    }
    PG8_WAIT_V(0);
    if constexpr (!ALIGN_EPI) { if (wr == 0) PG8_BAR; }
    PG8_BAR;
    if constexpr (Epi::AFTER_DRAIN) { E.fused(acc, cur, wr, wc, fr, fq, lds, wid, lane); S.done(cur); }
#undef PG8_SA
#undef PG8_SB
#undef PG8_STAGE
#undef PG8_LDA
#undef PG8_LDB
#undef PG8_MMA
#undef PG8_WAIT_V
#undef PG8_WAIT_L
#undef PG8_BAR
#undef PG8_SCHED
}
}

#define LAS __attribute__((address_space(3)))
using pg8::bf16_t; using pg8::bf16x8; using pg8::f32x4; using pg8::u32x4; using pg8::Unit; using pg8::cvt_pk_bf16;
typedef float f32x16 __attribute__((ext_vector_type(16)));
typedef unsigned u32x2 __attribute__((ext_vector_type(2)));
typedef short v4i16_t __attribute__((ext_vector_type(4)));

constexpr int MP = 32 * 2048, MS = 32 * 32, MT = MP + MS;
constexpr int DIN = 3080, NQKV = 3072, DFF = 2816, PLE = 256;
constexpr int TA_S = 544, TB_S = 4128;
constexpr float EPS = 1e-6f, LOG2E = 1.4426950408889634f, QSCALE = 0.125f * LOG2E, NEGB = -1e30f;
constexpr size_t O_Y = 0, O_KA_P = (size_t)MT * 1024, O_VA_P = O_KA_P + 32u * 512 * 512, O_KB_P = O_VA_P + 32u * 512 * 512, O_VB_P = O_KB_P + (size_t)MP * 512,
                 O_LF_P = O_VB_P + (size_t)MP * 512, O_KA_S = O_LF_P + (size_t)MP * 8, O_VA_S = O_KA_S + (size_t)MS * 512, O_KB_S = O_VA_S + (size_t)MS * 512,
                 O_VB_S = O_KB_S + (size_t)MS * 512, O_LF_S = O_VB_S + (size_t)MS * 512, O_END = O_LF_S + (size_t)MS * 8;
constexpr size_t MiB = 1u << 20;
constexpr size_t WS_WQKV = 1 * MiB, WS_WO = 7 * MiB, WS_WGU = 9 * MiB, WS_WD = 20 * MiB, WS_WPG = 26 * MiB, WS_WPP = 28 * MiB, WS_GAINS = 28 * MiB + 768 * 1024, WS_RSTD0 = 29 * MiB, WS_SSQ1 = 30 * MiB, WS_SSQ2 = 35 * MiB;
constexpr size_t WS_XB = 40 * MiB, WS_PB = 170 * MiB, WS_O = 203 * MiB, WS_QKVP = 333 * MiB, WS_H = 333 * MiB;
constexpr size_t WS_QAS = 717 * MiB, WS_QBS = 718 * MiB, WS_KAN = 719 * MiB, WS_VAN = 720 * MiB, WS_KBN = 721 * MiB, WS_VBN = 722 * MiB, WS_PP = 723 * MiB, WS_END = 853 * MiB;
constexpr size_t PSTRIDE = (size_t)32 * 8 * 2048 * 64;
constexpr int LDS_BYTES = 147456;

struct Args { const float* in[25]; float* out; unsigned char* ws; int ph_lo, ph_hi; };

__device__ __forceinline__ int lane_id_fresh() { int l; asm volatile("v_mbcnt_lo_u32_b32 %0, -1, 0\n\tv_mbcnt_hi_u32_b32 %0, -1, %0" : "=v"(l)); return l; }
__device__ __forceinline__ float wave_sum(float v) {
#pragma unroll
    for (int o = 1; o < 64; o <<= 1) v += __shfl_xor(v, o);
    return v;
}
__device__ __forceinline__ float bf_lo(unsigned u) { return __uint_as_float(u << 16); }
__device__ __forceinline__ float bf_hi(unsigned u) { return __uint_as_float(u & 0xffff0000u); }
__device__ __forceinline__ float fast_rcp(float x) { return __builtin_amdgcn_rcpf(x); }
__device__ __forceinline__ float fast_exp2(float x) { return __builtin_amdgcn_exp2f(x); }

struct EpiQKV {
    static constexpr bool PERM = true, AFTER_DRAIN = false;
    const float* rstd0; const float* gains; unsigned char* ws; float* out;
    __device__ __forceinline__ void operator()(const f32x4 (&acc)[2][2][4][2], const Unit& u, int wr, int wc, int fr, int fq) const {
        const int kind = u.pn >> 1, head = ((u.pn & 1) << 2) + wc, sub = kind % 3; const bool isB = kind >= 3;
        f32x4 gn[2][2];
        if (sub != 2) { const float* gp = gains + ((isB ? 2 : 0) + sub) * 64; const float sc = sub == 0 ? QSCALE : 1.0f;
#pragma unroll
            for (int bj = 0; bj < 2; ++bj)
#pragma unroll
                for (int n = 0; n < 2; ++n) gn[bj][n] = *(const f32x4*)(gp + 32 * bj + 8 * fq + 4 * n) * sc; }
        else { gn[0][0] = gn[0][1] = gn[1][0] = gn[1][1] = (f32x4){1.f, 1.f, 1.f, 1.f}; }
#pragma unroll
        for (int ai = 0; ai < 2; ++ai)
#pragma unroll
            for (int m = 0; m < 4; ++m) {
                const int rl = ai * 128 + wr * 64 + m * 16 + fr, row = u.pm * 256 + rl;
                const float rs = rstd0[row];
                f32x4 v[2][2];
#pragma unroll
                for (int bj = 0; bj < 2; ++bj)
#pragma unroll
                    for (int n = 0; n < 2; ++n) v[bj][n] = acc[ai][bj][m][n] * rs;
                if (sub != 2) {
                    float ss = 0.f;
#pragma unroll
                    for (int bj = 0; bj < 2; ++bj)
#pragma unroll
                        for (int n = 0; n < 2; ++n) { const f32x4 x = v[bj][n]; ss += (x[0] * x[0] + x[1] * x[1]) + (x[2] * x[2] + x[3] * x[3]); }
                    ss += __shfl_xor(ss, 16); ss += __shfl_xor(ss, 32);
                    const float hr = rsqrtf(ss * (1.0f / 64.0f) + EPS);
#pragma unroll
                    for (int bj = 0; bj < 2; ++bj)
#pragma unroll
                        for (int n = 0; n < 2; ++n) v[bj][n] = v[bj][n] * hr * gn[bj][n];
                }
                bf16_t* dst; float* fo = nullptr;
                if (u.pm < 256) {
                    const int b = u.pm >> 3, t = ((u.pm & 7) << 8) + rl;
                    dst = (bf16_t*)(ws + WS_QKVP) + (size_t)kind * PSTRIDE + ((size_t)(b * 8 + head) * 2048 + t) * 64;
                    if (sub != 0) {
                        if (isB) fo = out + (sub == 1 ? O_KB_P : O_VB_P) + ((size_t)(b * 2048 + t) * 8 + head) * 64;
                        else if (t >= 1536) fo = out + (sub == 1 ? O_KA_P : O_VA_P) + ((size_t)(b * 512 + (t - 1536)) * 8 + head) * 64;
                    }
                } else {
                    const int rp = (u.pm - 256) * 256 + rl, b = rp >> 5, t = rp & 31;
                    if (sub == 0) dst = (bf16_t*)(ws + (isB ? WS_QBS : WS_QAS)) + ((size_t)(b * 8 + head) * 32 + t) * 64;
                    else if (!isB) { dst = (bf16_t*)(ws + (sub == 1 ? WS_KAN : WS_VAN)) + ((size_t)(b * 8 + head) * 32 + t) * 64;
                                     fo = out + (sub == 1 ? O_KA_S : O_VA_S) + ((size_t)(b * 32 + t) * 8 + head) * 64; }
                    else { dst = (bf16_t*)(ws + (sub == 1 ? WS_KBN : WS_VBN)) + ((size_t)(b * 8 + head) * 32 + t) * 64;
                           fo = out + (sub == 1 ? O_KB_S : O_VB_S) + ((size_t)(b * 32 + t) * 8 + head) * 64; }
                }
#pragma unroll
                for (int bj = 0; bj < 2; ++bj) {
                    const int col = 32 * bj + 8 * fq; const f32x4 v0 = v[bj][0], v1 = v[bj][1];
                    u32x4 w; w.x = cvt_pk_bf16(v0[0], v0[1]); w.y = cvt_pk_bf16(v0[2], v0[3]); w.z = cvt_pk_bf16(v1[0], v1[1]); w.w = cvt_pk_bf16(v1[2], v1[3]);
                    *(u32x4*)(dst + col) = w;
                    if (fo) { *(f32x4*)(fo + col) = v0; *(f32x4*)(fo + col + 4) = v1; }
                }
            }
    }
};
struct EpiStore {
    static constexpr bool PERM = true, AFTER_DRAIN = false;
    bf16_t* O; int ldc;
    __device__ __forceinline__ void operator()(const f32x4 (&acc)[2][2][4][2], const Unit& u, int wr, int wc, int fr, int fq) const {
#pragma unroll
        for (int ai = 0; ai < 2; ++ai)
#pragma unroll
            for (int m = 0; m < 4; ++m) { const int row = u.pm * 256 + ai * 128 + wr * 64 + m * 16 + fr;
#pragma unroll
                for (int bj = 0; bj < 2; ++bj) { const int col = u.pn * 256 + 128 * bj + 32 * wc + 8 * fq; const f32x4 v0 = acc[ai][bj][m][0], v1 = acc[ai][bj][m][1];
                    u32x4 w; w.x = cvt_pk_bf16(v0[0], v0[1]); w.y = cvt_pk_bf16(v0[2], v0[3]); w.z = cvt_pk_bf16(v1[0], v1[1]); w.w = cvt_pk_bf16(v1[2], v1[3]);
                    *(u32x4*)(O + (size_t)row * ldc + col) = w; } }
    }
};
template <bool F32BASE> struct EpiRes {
    static constexpr bool PERM = true, AFTER_DRAIN = false;
    const float* base_p; const float* base_s; bf16_t* xb; float* ssq;
    __device__ __forceinline__ void operator()(const f32x4 (&acc)[2][2][4][2], const Unit& u, int wr, int wc, int fr, int fq) const {
#pragma unroll
        for (int ai = 0; ai < 2; ++ai)
#pragma unroll
            for (int m = 0; m < 4; ++m) { const int row = u.pm * 256 + ai * 128 + wr * 64 + m * 16 + fr;
                const float* bp = (u.pm < 256) ? base_p + (size_t)row * 1024 : base_s + (size_t)(row - MP) * 1024;
                float s = 0.f;
#pragma unroll
                for (int bj = 0; bj < 2; ++bj) { const int col = u.pn * 256 + 128 * bj + 32 * wc + 8 * fq;
                    f32x4 r0, r1;
                    if (F32BASE) { r0 = *(const f32x4*)(bp + col); r1 = *(const f32x4*)(bp + col + 4); }
                    else { const u32x4 rw = *(const u32x4*)(xb + (size_t)row * 1024 + col); r0 = (f32x4){bf_lo(rw.x), bf_hi(rw.x), bf_lo(rw.y), bf_hi(rw.y)}; r1 = (f32x4){bf_lo(rw.z), bf_hi(rw.z), bf_lo(rw.w), bf_hi(rw.w)}; }
                    const f32x4 v0 = acc[ai][bj][m][0] + r0, v1 = acc[ai][bj][m][1] + r1;
                    u32x4 w; w.x = cvt_pk_bf16(v0[0], v0[1]); w.y = cvt_pk_bf16(v0[2], v0[3]); w.z = cvt_pk_bf16(v1[0], v1[1]); w.w = cvt_pk_bf16(v1[2], v1[3]);
                    *(u32x4*)(xb + (size_t)row * 1024 + col) = w;
                    s += (v0[0] * v0[0] + v0[1] * v0[1]) + (v0[2] * v0[2] + v0[3] * v0[3]) + (v1[0] * v1[0] + v1[1] * v1[1]) + (v1[2] * v1[2] + v1[3] * v1[3]); }
                s += __shfl_xor(s, 16); s += __shfl_xor(s, 32);
                if (fq == 0) ssq[(size_t)row * 16 + u.pn * 4 + wc] = s; }
    }
};
__device__ __forceinline__ float row_rstd(const float* ssq, int row) {
    const f32x4 a = *(const f32x4*)(ssq + (size_t)row * 16), b = *(const f32x4*)(ssq + (size_t)row * 16 + 4), c = *(const f32x4*)(ssq + (size_t)row * 16 + 8), d = *(const f32x4*)(ssq + (size_t)row * 16 + 12);
    const float t = ((a[0] + a[1]) + (a[2] + a[3])) + ((b[0] + b[1]) + (b[2] + b[3])) + ((c[0] + c[1]) + (c[2] + c[3])) + ((d[0] + d[1]) + (d[2] + d[3]));
    return rsqrtf(t * (1.0f / 1024.0f) + EPS);
}
struct EpiSwiGLU {
    static constexpr bool PERM = true, AFTER_DRAIN = false;
    const float* ssq; bf16_t* H;
    __device__ __forceinline__ void operator()(const f32x4 (&acc)[2][2][4][2], const Unit& u, int wr, int wc, int fr, int fq) const {
#pragma unroll
        for (int ai = 0; ai < 2; ++ai)
#pragma unroll
            for (int m = 0; m < 4; ++m) { const int row = u.pm * 256 + ai * 128 + wr * 64 + m * 16 + fr; const float rs = row_rstd(ssq, row);
                float hv[8];
#pragma unroll
                for (int n = 0; n < 2; ++n)
#pragma unroll
                    for (int e = 0; e < 4; ++e) { const float g = acc[ai][0][m][n][e] * rs, up = acc[ai][1][m][n][e] * rs;
                        hv[4 * n + e] = g * up * fast_rcp(1.0f + fast_exp2(-g * LOG2E)); }
                u32x4 w; w.x = cvt_pk_bf16(hv[0], hv[1]); w.y = cvt_pk_bf16(hv[2], hv[3]); w.z = cvt_pk_bf16(hv[4], hv[5]); w.w = cvt_pk_bf16(hv[6], hv[7]);
                *(u32x4*)(H + (size_t)row * DFF + u.pn * 128 + 32 * wc + 8 * fq) = w; }
    }
};
struct EpiPle {
    static constexpr bool PERM = true, AFTER_DRAIN = false;
    const float* ssq; const bf16_t* PP; const bf16_t* xb; float* y;
    __device__ __forceinline__ void operator()(const f32x4 (&acc)[2][2][4][2], const Unit& u, int wr, int wc, int fr, int fq) const {
#pragma unroll
        for (int ai = 0; ai < 2; ++ai)
#pragma unroll
            for (int m = 0; m < 4; ++m) { const int row = u.pm * 256 + ai * 128 + wr * 64 + m * 16 + fr; const float rs = row_rstd(ssq, row);
#pragma unroll
                for (int bj = 0; bj < 2; ++bj) { const int col = u.pn * 256 + 128 * bj + 32 * wc + 8 * fq; float* yp = y + (size_t)row * 1024 + col;
                    const u32x4 pw = __builtin_nontemporal_load((const u32x4*)(PP + (size_t)row * 1024 + col));
                    const u32x4 xw = *(const u32x4*)(xb + (size_t)row * 1024 + col);
                    const f32x4 x0 = (f32x4){bf_lo(xw.x), bf_hi(xw.x), bf_lo(xw.y), bf_hi(xw.y)}, x1 = (f32x4){bf_lo(xw.z), bf_hi(xw.z), bf_lo(xw.w), bf_hi(xw.w)};
                    const f32x4 a0 = acc[ai][bj][m][0] * rs, a1 = acc[ai][bj][m][1] * rs;
                    f32x4 o0, o1;
                    o0[0] = x0[0] + bf_lo(pw.x) * fast_rcp(1.0f + fast_exp2(-a0[0] * LOG2E)); o0[1] = x0[1] + bf_hi(pw.x) * fast_rcp(1.0f + fast_exp2(-a0[1] * LOG2E));
                    o0[2] = x0[2] + bf_lo(pw.y) * fast_rcp(1.0f + fast_exp2(-a0[2] * LOG2E)); o0[3] = x0[3] + bf_hi(pw.y) * fast_rcp(1.0f + fast_exp2(-a0[3] * LOG2E));
                    o1[0] = x1[0] + bf_lo(pw.z) * fast_rcp(1.0f + fast_exp2(-a1[0] * LOG2E)); o1[1] = x1[1] + bf_hi(pw.z) * fast_rcp(1.0f + fast_exp2(-a1[1] * LOG2E));
                    o1[2] = x1[2] + bf_lo(pw.w) * fast_rcp(1.0f + fast_exp2(-a1[2] * LOG2E)); o1[3] = x1[3] + bf_hi(pw.w) * fast_rcp(1.0f + fast_exp2(-a1[3] * LOG2E));
                    *(f32x4*)yp = o0; *(f32x4*)(yp + 4) = o1; } }
    }
};

__device__ __forceinline__ void tr_item(const float* W, int ldw, int K, int srccol0, bf16_t* WT, int dstrow0, const float* gain, LAS float* scr, int kb, int lane) {
    const int k0 = 64 * kb;
#pragma unroll 8
    for (int i = 0; i < 32; ++i) { const int kk = 2 * i + (lane >> 5); float v = __builtin_nontemporal_load(W + (size_t)(k0 + kk) * ldw + srccol0 + (lane & 31)); if (gain) v *= gain[k0 + kk]; scr[kk * 33 + (lane & 31)] = v; }
    asm volatile("s_waitcnt lgkmcnt(0)" ::: "memory");
    const int c = lane & 7;
#pragma unroll
    for (int j = 0; j < 4; ++j) { const int n = (lane >> 3) + 8 * j; const LAS float* s = scr + (8 * c) * 33 + n;
        u32x4 o; o.x = cvt_pk_bf16(s[0 * 33], s[1 * 33]); o.y = cvt_pk_bf16(s[2 * 33], s[3 * 33]); o.z = cvt_pk_bf16(s[4 * 33], s[5 * 33]); o.w = cvt_pk_bf16(s[6 * 33], s[7 * 33]);
        *(u32x4*)(WT + (size_t)(dstrow0 + n) * K + k0 + 8 * c) = o; }
    asm volatile("s_waitcnt lgkmcnt(0)" ::: "memory");
}
__device__ __forceinline__ void cvt8(const float* src, bf16_t* dst) {
    const f32x4 a = *(const f32x4*)src, b = *(const f32x4*)(src + 4);
    u32x4 w; w.x = cvt_pk_bf16(a[0], a[1]); w.y = cvt_pk_bf16(a[2], a[3]); w.z = cvt_pk_bf16(b[0], b[1]); w.w = cvt_pk_bf16(b[2], b[3]);
    *(u32x4*)dst = w;
}
__device__ __forceinline__ void tr_set(const Args& a, LAS unsigned char* lds, int wave, int lane, const int set, int gw, int NGW) {
    unsigned char* ws = a.ws;
    LAS float* scr = (LAS float*)(lds + wave * 16384);
    constexpr int I_QKV = 16 * 96, I_O = 16 * 32, I_GU = 16 * 176, I_D = 44 * 32, I_PG = 16 * 32, I_PP = 4 * 32;
    const int ntot = set == 0 ? I_QKV : (set == 1 ? I_O + I_GU : I_D + I_PG + I_PP);
    for (int it = gw; it < ntot; it += NGW) {
        int r = it;
        if (set == 0) { const int kb = r / 96, nb = r % 96, pn = nb >> 3, bj = (nb >> 2) & 1, wc = nb & 3;
            tr_item(a.in[10], DIN, 1024, 256 * pn + 64 * wc + 32 * bj, (bf16_t*)(ws + WS_WQKV), 32 * nb, a.in[9], scr, kb, lane); continue; }
        if (set == 1) {
            if (r < I_O) { const int kb = r / 32, nb = r % 32; tr_item(a.in[17], 1024, 1024, 32 * nb, (bf16_t*)(ws + WS_WO), 32 * nb, nullptr, scr, kb, lane); continue; } r -= I_O;
            { const int kb = r / 176, nb = r % 176, pn = nb >> 3, bj = (nb >> 2) & 1, q = nb & 3;
              tr_item(bj ? a.in[20] : a.in[19], DFF, 1024, 128 * pn + 32 * q, (bf16_t*)(ws + WS_WGU), 32 * nb, a.in[18], scr, kb, lane); continue; }
        }
        if (r < I_D) { const int kb = r / 32, nb = r % 32; tr_item(a.in[21], 1024, DFF, 32 * nb, (bf16_t*)(ws + WS_WD), 32 * nb, nullptr, scr, kb, lane); continue; } r -= I_D;
        if (r < I_PG) { const int kb = r / 32, nb = r % 32; tr_item(a.in[23], 1024, 1024, 32 * nb, (bf16_t*)(ws + WS_WPG), 32 * nb, a.in[22], scr, kb, lane); continue; } r -= I_PG;
        { const int kb = r / 32, nb = r % 32; tr_item(a.in[24], 1024, PLE, 32 * nb, (bf16_t*)(ws + WS_WPP), 32 * nb, nullptr, scr, kb, lane); }
    }
}
__device__ __forceinline__ void shadow_share(int nu, int G, int c, int& rank, int& count) {
    const int tailc = nu - (nu / G) * G; const bool split = tailc > 0 && tailc * 2 < G;
    if (!split) { rank = c; count = G; } else if (c >= tailc) { rank = c - tailc; count = G - tailc; } else { rank = 0; count = 0; }
}
__device__ __forceinline__ void p_convert(const Args& a, const size_t gt, const size_t NT) {
    unsigned char* ws = a.ws;
    for (size_t i0 = gt; i0 < (size_t)MT * 32; i0 += 4 * NT) {
        f32x4 r[4][2];
#pragma unroll
        for (int q = 0; q < 4; ++q) { const size_t i = i0 + q * NT; if (i < (size_t)MT * 32) { const size_t row = i >> 5; const int c8 = (int)(i & 31);
            const float* src = row < (size_t)MP ? a.in[7] + row * 256 + c8 * 8 : a.in[8] + (row - MP) * 256 + c8 * 8; r[q][0] = __builtin_nontemporal_load((const f32x4*)src); r[q][1] = __builtin_nontemporal_load((const f32x4*)(src + 4)); } }
#pragma unroll
        for (int q = 0; q < 4; ++q) { const size_t i = i0 + q * NT; if (i < (size_t)MT * 32) {
            u32x4 w; w.x = cvt_pk_bf16(r[q][0][0], r[q][0][1]); w.y = cvt_pk_bf16(r[q][0][2], r[q][0][3]); w.z = cvt_pk_bf16(r[q][1][0], r[q][1][1]); w.w = cvt_pk_bf16(r[q][1][2], r[q][1][3]);
            *(u32x4*)((bf16_t*)(ws + WS_PB) + i * 8) = w; } }
    }
}
__device__ __forceinline__ void phase0(const Args& a, LAS unsigned char* lds, int wave) {
    const int lane = lane_id_fresh(), tid = wave * 64 + lane;
    unsigned char* ws = a.ws;
    const int gw = blockIdx.x * 8 + wave, NGW = gridDim.x * 8;
    tr_set(a, lds, wave, lane, 0, gw, NGW);
    if (blockIdx.x == 0 && tid < 256) { const int w = tid >> 6, d = tid & 63; ((float*)(ws + WS_GAINS))[tid] = a.in[12 + w][d]; }
    if (blockIdx.x == 0 && wave == 0) {
        float ga = fabsf(a.in[12][lane]), ka = fabsf(a.in[13][lane]), gb = fabsf(a.in[14][lane]), kb = fabsf(a.in[15][lane]);
#pragma unroll
        for (int o = 1; o < 64; o <<= 1) { ga = fmaxf(ga, __shfl_xor(ga, o)); ka = fmaxf(ka, __shfl_xor(ka, o)); gb = fmaxf(gb, __shfl_xor(gb, o)); kb = fmaxf(kb, __shfl_xor(kb, o)); }
        if (lane == 0) { ((float*)(ws + WS_GAINS))[256] = 64.0f * QSCALE * ga * ka + 1.0f; ((float*)(ws + WS_GAINS))[257] = 64.0f * QSCALE * gb * kb + 1.0f; }
    }
    if (blockIdx.x == 0) {
        const float* tb = a.in[16] + wave * 257;
        float mx = fmaxf(fmaxf(tb[lane], tb[lane + 64]), fmaxf(tb[lane + 128], tb[lane + 192])); mx = fmaxf(mx, tb[256]);
#pragma unroll
        for (int o = 1; o < 64; o <<= 1) mx = fmaxf(mx, __shfl_xor(mx, o));
        if (lane == 0) ((float*)(ws + WS_GAINS))[264 + wave] = mx;
    }
    __syncthreads();
    {
        LAS float* wf = (LAS float*)lds;
        for (int i = tid; i < 8192; i += 512) { const int j = i >> 10, k = i & 1023; wf[i] = a.in[9][k] * a.in[10][(size_t)k * DIN + 3072 + j]; }
        __syncthreads();
        f32x4 wr[8][4];
#pragma unroll
        for (int jj = 0; jj < 8; ++jj)
#pragma unroll
            for (int j = 0; j < 4; ++j) wr[jj][j] = *(const LAS f32x4*)(wf + jj * 1024 + (lane + 64 * j) * 4);
        for (int row0 = gw; row0 < MT; row0 += 2 * NGW) {
            f32x4 vv[2][4];
#pragma unroll
            for (int rr = 0; rr < 2; ++rr) { const int row = row0 + rr * NGW < MT ? row0 + rr * NGW : row0;
                const float* xr = row < MP ? a.in[0] + (size_t)row * 1024 : a.in[1] + (size_t)(row - MP) * 1024;
#pragma unroll
                for (int j = 0; j < 4; ++j) vv[rr][j] = __builtin_nontemporal_load((const f32x4*)xr + lane + 64 * j); }
#pragma unroll
            for (int rr = 0; rr < 2; ++rr) {
                const int row = row0 + rr * NGW;
                if (row >= MT) break;
                f32x4 v[4];
#pragma unroll
                for (int j = 0; j < 4; ++j) v[j] = vv[rr][j];
                float ss = 0.f;
#pragma unroll
                for (int j = 0; j < 4; ++j) ss += (v[j][0] * v[j][0] + v[j][1] * v[j][1]) + (v[j][2] * v[j][2] + v[j][3] * v[j][3]);
                u32x2* xo = (u32x2*)((bf16_t*)(ws + WS_XB) + (size_t)row * 1024);
#pragma unroll
                for (int j = 0; j < 4; ++j) { u32x2 w; w.x = cvt_pk_bf16(v[j][0], v[j][1]); w.y = cvt_pk_bf16(v[j][2], v[j][3]); xo[lane + 64 * j] = w; }
                float d[8];
#pragma unroll
                for (int jj = 0; jj < 8; ++jj) { float t = 0.f;
#pragma unroll
                    for (int j = 0; j < 4; ++j) { const f32x4 w = wr[jj][j]; t += (v[j][0] * w[0] + v[j][1] * w[1]) + (v[j][2] * w[2] + v[j][3] * w[3]); }
                    d[jj] = t; }
                const bool b5 = (lane & 32) != 0, b4 = (lane & 16) != 0, b3 = (lane & 8) != 0;
                float e4[4], e2[2];
#pragma unroll
                for (int j = 0; j < 4; ++j) { const float snd = b5 ? d[j] : d[j + 4], kp = b5 ? d[j + 4] : d[j]; e4[j] = kp + __shfl_xor(snd, 32); }
#pragma unroll
                for (int j = 0; j < 2; ++j) { const float snd = b4 ? e4[j] : e4[j + 2], kp = b4 ? e4[j + 2] : e4[j]; e2[j] = kp + __shfl_xor(snd, 16); }
                float g; { const float snd = b3 ? e2[0] : e2[1], kp = b3 ? e2[1] : e2[0]; g = kp + __shfl_xor(snd, 8); }
                g += __shfl_xor(g, 4); g += __shfl_xor(g, 2); g += __shfl_xor(g, 1);
                const float rstd = rsqrtf(wave_sum(ss) * (1.0f / 1024.0f) + EPS);
                if ((lane & 7) == 0) { const int k = lane >> 3; g = g * rstd + a.in[11][k]; const float lf = fminf(g, 0.f) - log1pf(expf(-fabsf(g)));
                    float* dst = row < MP ? a.out + O_LF_P + (size_t)row * 8 : a.out + O_LF_S + (size_t)(row - MP) * 8; dst[k] = lf; }
                if (lane == 0) ((float*)(ws + WS_RSTD0))[row] = rstd;
            }
        }
    }
}

__device__ __forceinline__ int crow(int r, int hi) { return (r & 3) + 8 * (r >> 2) + 4 * hi; }
__device__ __forceinline__ void split3(float t, unsigned& h, unsigned& m, unsigned& l) {
    h = cvt_pk_bf16(t, 0.f) & 0xffffu; const float r1 = t - __uint_as_float(h << 16);
    m = cvt_pk_bf16(r1, 0.f) & 0xffffu; const float r2 = r1 - __uint_as_float(m << 16);
    l = cvt_pk_bf16(r2, 0.f) & 0xffffu;
}
__device__ __forceinline__ float qk_bound(const unsigned char* ws, const bool modeB, int lane) {
    (void)lane; return *(volatile const float*)((const float*)(ws + WS_GAINS) + 256 + (modeB ? 1 : 0));
}
__device__ __forceinline__ bf16x8 pack8(float a0, float a1, float a2, float a3, float a4, float a5, float a6, float a7) {
    u32x4 w; w.x = cvt_pk_bf16(a0, a1); w.y = cvt_pk_bf16(a2, a3); w.z = cvt_pk_bf16(a4, a5); w.w = cvt_pk_bf16(a6, a7); return __builtin_bit_cast(bf16x8, w);
}
constexpr int A_KS = 0, A_VS = 36864, A_TAB = 73728, A_TSP = 81920, A_WSF = 98304, A_SCAN = 100352, KVT = 128 * 72;
__device__ __forceinline__ void attn_tile(const LAS bf16_t* Kt, const LAS bf16_t* Vt, const bf16x8 (&qr)[4], const LAS float* tab, LAS float* wsf, const bool modeB, const int kb0, const int qw,
                                          const int lane, f32x16& o0, f32x16& o1, float& mrun, float& lrun, const bf16x8 bq = (bf16x8){0, 0, 0, 0, 0, 0, 0, 0}, const LAS u32x2* tsp = nullptr) {
    const int r32 = lane & 31, hi = lane >> 5, qa = qw + r32;
    bf16x8 kf0[4], kf1[4];
#pragma unroll
    for (int d0 = 0; d0 < 4; ++d0) { kf0[d0] = *(const LAS bf16x8*)(Kt + r32 * 72 + d0 * 16 + hi * 8); kf1[d0] = *(const LAS bf16x8*)(Kt + (32 + r32) * 72 + d0 * 16 + hi * 8); }
    const LAS bf16_t* vb = Vt + (4 * hi + ((lane & 15) >> 2)) * 72 + 16 * ((lane >> 4) & 1) + 4 * (lane & 3);
    v4i16_t vlo[8], vup[8];
#pragma unroll
    for (int g = 0; g < 4; ++g)
#pragma unroll
        for (int d0 = 0; d0 < 2; ++d0) {
            vlo[2 * g + d0] = __builtin_amdgcn_ds_read_tr16_b64_v4i16((LAS v4i16_t*)(vb + (16 * g) * 72 + 32 * d0));
            vup[2 * g + d0] = __builtin_amdgcn_ds_read_tr16_b64_v4i16((LAS v4i16_t*)(vb + (16 * g + 8) * 72 + 32 * d0)); }
    f32x16 p0, p1;
    bf16x8 ab0, ab1;
    if (modeB) {
        const u32x2 t0 = tsp[kb0 + r32], t1 = tsp[kb0 + 32 + r32];
        ab0 = __builtin_bit_cast(bf16x8, (u32x4){t0.x, t0.y, 0x3F803F80u, 0u}); ab1 = __builtin_bit_cast(bf16x8, (u32x4){t1.x, t1.y, 0x3F803F80u, 0u});
#pragma unroll
        for (int r = 0; r < 16; ++r) { p0[r] = 0.f; p1[r] = 0.f; }
    } else {
        if (qw - (kb0 + 63) >= 128) { const float c = tab[256];
#pragma unroll
            for (int r = 0; r < 16; ++r) { p0[r] = c; p1[r] = c; } }
        else {
#pragma unroll
            for (int r = 0; r < 16; ++r) { const int rel = qa - (kb0 + crow(r, hi)); int i0 = rel < -128 ? -128 : rel; i0 = i0 > 128 ? 128 : i0; int i1 = rel - 32 < -128 ? -128 : rel - 32; i1 = i1 > 128 ? 128 : i1;
                p0[r] = tab[i0 + 128]; p1[r] = tab[i1 + 128]; } }
    }
    if (modeB) { p0 = __builtin_amdgcn_mfma_f32_32x32x16_bf16(ab0, bq, p0, 0, 0, 0); p1 = __builtin_amdgcn_mfma_f32_32x32x16_bf16(ab1, bq, p1, 0, 0, 0); }
#pragma unroll
    for (int d0 = 0; d0 < 4; ++d0) {
        p0 = __builtin_amdgcn_mfma_f32_32x32x16_bf16(kf0[d0], qr[d0], p0, 0, 0, 0);
        p1 = __builtin_amdgcn_mfma_f32_32x32x16_bf16(kf1[d0], qr[d0], p1, 0, 0, 0);
    }
    if (modeB && kb0 + 63 > qw) {
#pragma unroll
        for (int r = 0; r < 16; ++r) { const int kk = kb0 + crow(r, hi); if (kk > qa) p0[r] = NEGB; if (kk + 32 > qa) p1[r] = NEGB; } }
    float sum = 0.f;
#pragma unroll
    for (int r = 0; r < 16; ++r) { p0[r] = fast_exp2(p0[r]); p1[r] = fast_exp2(p1[r]); sum += p0[r] + p1[r]; }
    lrun += sum;
    bf16x8 pa[4];
    pa[0] = pack8(p0[0], p0[1], p0[2], p0[3], p0[4], p0[5], p0[6], p0[7]); pa[1] = pack8(p0[8], p0[9], p0[10], p0[11], p0[12], p0[13], p0[14], p0[15]);
    pa[2] = pack8(p1[0], p1[1], p1[2], p1[3], p1[4], p1[5], p1[6], p1[7]); pa[3] = pack8(p1[8], p1[9], p1[10], p1[11], p1[12], p1[13], p1[14], p1[15]);
#pragma unroll
    for (int g = 0; g < 4; ++g) {
#pragma unroll
        for (int d0 = 0; d0 < 2; ++d0) {
            const v4i16_t lo = vlo[2 * g + d0], up = vup[2 * g + d0];
            const bf16x8 vf = (bf16x8){lo[0], lo[1], lo[2], lo[3], up[0], up[1], up[2], up[3]};
            if (d0 == 0) o0 = __builtin_amdgcn_mfma_f32_32x32x16_bf16(pa[g], vf, o0, 0, 0, 0);
            else         o1 = __builtin_amdgcn_mfma_f32_32x32x16_bf16(pa[g], vf, o1, 0, 0, 0);
        }
    }
}
__device__ __forceinline__ void attn_bias_init(f32x16& p0, f32x16& p1, const LAS float* tab, const bool modeB, const int kb0, const int qw, const int qa, const int hi) {
    if (modeB) {
#pragma unroll
        for (int rg = 0; rg < 4; ++rg) { const f32x4 c0 = *(const LAS f32x4*)(tab + kb0 + 8 * rg + 4 * hi), c1 = *(const LAS f32x4*)(tab + kb0 + 32 + 8 * rg + 4 * hi);
#pragma unroll
            for (int i = 0; i < 4; ++i) { p0[4 * rg + i] = c0[i]; p1[4 * rg + i] = c1[i]; } }
    } else if (qw - (kb0 + 63) >= 128) { const float c = tab[256];
#pragma unroll
        for (int r = 0; r < 16; ++r) { p0[r] = c; p1[r] = c; }
    } else {
#pragma unroll
        for (int r = 0; r < 16; ++r) { const int rel = qa - (kb0 + crow(r, hi)); int i0 = rel < -128 ? -128 : rel; i0 = i0 > 128 ? 128 : i0; int i1 = rel - 32 < -128 ? -128 : rel - 32; i1 = i1 > 128 ? 128 : i1;
            p0[r] = tab[i0 + 128]; p1[r] = tab[i1 + 128]; }
    }
}
__device__ __forceinline__ void attn_softmax_pv(f32x16& p0, f32x16& p1, const LAS bf16_t* Vt, LAS float* wsf, const int lane, f32x16& o0, f32x16& o1, float& mrun, float& lrun) {
    const int r32 = lane & 31, hi = lane >> 5;
    float mx = fmaxf(p0[0], p1[0]);
#pragma unroll
    for (int r = 1; r < 16; ++r) mx = fmaxf(mx, fmaxf(p0[r], p1[r]));
    mx = fmaxf(mx, __shfl_xor(mx, 32));
    const float mnew = fmaxf(mrun, mx), alpha = fast_exp2(mrun - mnew); mrun = mnew;
    wsf[r32] = alpha;
    float sum = 0.f;
#pragma unroll
    for (int r = 0; r < 16; ++r) { p0[r] = fast_exp2(p0[r] - mnew); p1[r] = fast_exp2(p1[r] - mnew); sum += p0[r] + p1[r]; }
    lrun = lrun * alpha + sum;
#pragma unroll
    for (int rg = 0; rg < 4; ++rg) { const f32x4 f = *(const LAS f32x4*)(wsf + 8 * rg + 4 * hi);
#pragma unroll
        for (int i = 0; i < 4; ++i) { o0[4 * rg + i] *= f[i]; o1[4 * rg + i] *= f[i]; } }
    bf16x8 pa[4];
    pa[0] = pack8(p0[0], p0[1], p0[2], p0[3], p0[4], p0[5], p0[6], p0[7]); pa[1] = pack8(p0[8], p0[9], p0[10], p0[11], p0[12], p0[13], p0[14], p0[15]);
    pa[2] = pack8(p1[0], p1[1], p1[2], p1[3], p1[4], p1[5], p1[6], p1[7]); pa[3] = pack8(p1[8], p1[9], p1[10], p1[11], p1[12], p1[13], p1[14], p1[15]);
    const LAS bf16_t* vb = Vt + (4 * hi + ((lane & 15) >> 2)) * 72 + 16 * ((lane >> 4) & 1) + 4 * (lane & 3);
#pragma unroll
    for (int g = 0; g < 4; ++g) {
#pragma unroll
        for (int d0 = 0; d0 < 2; ++d0) {
            const v4i16_t lo = __builtin_amdgcn_ds_read_tr16_b64_v4i16((LAS v4i16_t*)(vb + (16 * g) * 72 + 32 * d0));
            const v4i16_t up = __builtin_amdgcn_ds_read_tr16_b64_v4i16((LAS v4i16_t*)(vb + (16 * g + 8) * 72 + 32 * d0));
            const bf16x8 vf = (bf16x8){lo[0], lo[1], lo[2], lo[3], up[0], up[1], up[2], up[3]};
            if (d0 == 0) o0 = __builtin_amdgcn_mfma_f32_32x32x16_bf16(pa[g], vf, o0, 0, 0, 0);
            else         o1 = __builtin_amdgcn_mfma_f32_32x32x16_bf16(pa[g], vf, o1, 0, 0, 0);
        }
    }
}
__device__ __forceinline__ void attn_pair(const LAS bf16_t* Kt, const LAS bf16_t* Vt, const bf16x8 (&qr)[4], const LAS float* tab, LAS float* wsf, const bool modeB, const int kb0, const int qw,
                                          const int lane, f32x16& o0, f32x16& o1, float& mrun, float& lrun) {
    const int r32 = lane & 31, hi = lane >> 5, qa = qw + r32;
    f32x16 a0, a1, b0, b1;
    attn_bias_init(a0, a1, tab, modeB, kb0, qw, qa, hi); attn_bias_init(b0, b1, tab, modeB, kb0 + 64, qw, qa, hi);
#pragma unroll
    for (int d0 = 0; d0 < 4; ++d0) {
        const LAS bf16_t* kp = Kt + r32 * 72 + d0 * 16 + hi * 8;
        const bf16x8 k0 = *(const LAS bf16x8*)(kp), k1 = *(const LAS bf16x8*)(kp + 32 * 72), k2 = *(const LAS bf16x8*)(kp + 64 * 72), k3 = *(const LAS bf16x8*)(kp + 96 * 72);
        a0 = __builtin_amdgcn_mfma_f32_32x32x16_bf16(k0, qr[d0], a0, 0, 0, 0); a1 = __builtin_amdgcn_mfma_f32_32x32x16_bf16(k1, qr[d0], a1, 0, 0, 0);
        b0 = __builtin_amdgcn_mfma_f32_32x32x16_bf16(k2, qr[d0], b0, 0, 0, 0); b1 = __builtin_amdgcn_mfma_f32_32x32x16_bf16(k3, qr[d0], b1, 0, 0, 0);
    }
    attn_softmax_pv(a0, a1, Vt, wsf, lane, o0, o1, mrun, lrun);
    attn_softmax_pv(b0, b1, Vt + 64 * 72, wsf, lane, o0, o1, mrun, lrun);
}
__device__ __forceinline__ void attn_unit(const Args& a, LAS unsigned char* lds, const bool modeB, int bh, int wave) {
    const int lane = lane_id_fresh(), tid = wave * 64 + lane;
    unsigned char* ws = a.ws;
    const int b = bh >> 3, h = bh & 7, r32 = lane & 31, hi = lane >> 5;
    const size_t hb = (size_t)(b * 8 + h) * 2048 * 64; const bf16_t* base = (const bf16_t*)(ws + WS_QKVP) + (modeB ? 3 : 0) * PSTRIDE;
    const bf16_t* Q = base + hb; const bf16_t* K = base + PSTRIDE + hb; const bf16_t* V = base + 2 * PSTRIDE + hb;
    const size_t orow0 = (size_t)b * 2048;
    const int colbase = (modeB ? 512 : 0) + h * 64;
    LAS bf16_t* Ks = (LAS bf16_t*)(lds + A_KS); LAS bf16_t* Vs = (LAS bf16_t*)(lds + A_VS);
    LAS float* tab = (LAS float*)(lds + A_TAB); LAS float* wsf = (LAS float*)(lds + A_WSF) + wave * 64; LAS float* scanw = (LAS float*)(lds + A_SCAN); LAS u32x2* tsp = (LAS u32x2*)(lds + A_TSP);
    __syncthreads();
    if (modeB) {
        const int k0 = tid * 4;
        const float* lf0 = a.out + O_LF_P + (size_t)b * 2048 * 8 + h;
        float v0 = lf0[(size_t)k0 * 8], v1 = lf0[(size_t)(k0 + 1) * 8], v2 = lf0[(size_t)(k0 + 2) * 8], v3 = lf0[(size_t)(k0 + 3) * 8];
        const float loc = (v0 + v1) + (v2 + v3);
        float inc = loc;
#pragma unroll
        for (int o = 1; o < 64; o <<= 1) { const float y = __int_as_float(__builtin_amdgcn_ds_bpermute(((lane - o) & 63) << 2, __float_as_int(inc))); if (lane >= o) inc += y; }
        if (lane == 63) scanw[wave] = inc;
        __syncthreads();
        float run = inc - loc;
        for (int w = 0; w < wave; ++w) run += scanw[w];
        float tv[4]; run += v0; tv[0] = -run * LOG2E; run += v1; tv[1] = -run * LOG2E; run += v2; tv[2] = -run * LOG2E; run += v3; tv[3] = -run * LOG2E;
#pragma unroll
        for (int i = 0; i < 4; ++i) { tab[k0 + i] = tv[i]; unsigned hh, mm, ll; split3(tv[i], hh, mm, ll); tsp[k0 + i] = (u32x2){hh | (mm << 16), ll | 0x3F800000u}; }
    } else {
        for (int i = tid; i < 257; i += 512) tab[i] = a.in[16][h * 257 + i] * LOG2E;
    }
    __syncthreads();
    const float bqk = qk_bound(ws, modeB, lane);
    const int srow = tid >> 3, sch = tid & 7;
    for (int qb = 0; qb < 8; ++qb) {
        const int q0 = qb * 256, qw = q0 + 32 * wave;
        int tlo, thi, blo, bhi;
        if (modeB) { tlo = 0; thi = (qw + 31) >> 6; blo = 0; bhi = (q0 + 255) >> 6; }
        else { const int c = qw >> 6; tlo = c > 8 ? c - 8 : 0; thi = c; const int c0 = q0 >> 6; blo = c0 > 8 ? c0 - 8 : 0; bhi = (q0 + 224) >> 6; }
        const int Tlo = blo >> 1, Thi = bhi >> 1;
        bf16x8 qr[4];
#pragma unroll
        for (int d0 = 0; d0 < 4; ++d0) qr[d0] = *(const bf16x8*)(Q + (size_t)(qw + r32) * 64 + d0 * 16 + hi * 8);
        float mrun = (modeB ? tab[qw + r32] : 0.f) + bqk, lrun = 0.f; f32x16 o0 = {}, o1 = {};
        bf16x8 bq;
        { unsigned hh, mm, ll; split3(-mrun, hh, mm, ll);
          const u32x4 w = hi == 0 ? (u32x4){0x3F803F80u, 0x3F80u | (hh << 16), mm | (ll << 16), 0u} : (u32x4){0u, 0u, 0u, 0u}; bq = __builtin_bit_cast(bf16x8, w); }
        u32x4 kr0, kr1, vr0, vr1;
        { const size_t ro = (size_t)(128 * Tlo + srow) * 64 + sch * 8;
          kr0 = *(const u32x4*)(K + ro); kr1 = *(const u32x4*)(K + ro + 64 * 64); vr0 = *(const u32x4*)(V + ro); vr1 = *(const u32x4*)(V + ro + 64 * 64); }
        *(LAS u32x4*)(Ks + srow * 72 + sch * 8) = kr0; *(LAS u32x4*)(Ks + (64 + srow) * 72 + sch * 8) = kr1;
        *(LAS u32x4*)(Vs + srow * 72 + sch * 8) = vr0; *(LAS u32x4*)(Vs + (64 + srow) * 72 + sch * 8) = vr1;
        __syncthreads();
        for (int T = Tlo; T <= Thi; ++T) {
            const int cur = (T - Tlo) & 1;
            if (T < Thi) { const size_t ro = (size_t)(128 * (T + 1) + srow) * 64 + sch * 8;
                kr0 = *(const u32x4*)(K + ro); kr1 = *(const u32x4*)(K + ro + 64 * 64); vr0 = *(const u32x4*)(V + ro); vr1 = *(const u32x4*)(V + ro + 64 * 64); }
            const LAS bf16_t* Kt = Ks + cur * KVT; const LAS bf16_t* Vt = Vs + cur * KVT;
            if (2 * T >= tlo && 2 * T <= thi) attn_tile(Kt, Vt, qr, tab, wsf, modeB, 128 * T, qw, lane, o0, o1, mrun, lrun, bq, tsp);
            if (2 * T + 1 >= tlo && 2 * T + 1 <= thi) attn_tile(Kt + 64 * 72, Vt + 64 * 72, qr, tab, wsf, modeB, 128 * T + 64, qw, lane, o0, o1, mrun, lrun, bq, tsp);
            if (T < Thi) { LAS bf16_t* Kn = Ks + (cur ^ 1) * KVT; LAS bf16_t* Vn = Vs + (cur ^ 1) * KVT;
                *(LAS u32x4*)(Kn + srow * 72 + sch * 8) = kr0; *(LAS u32x4*)(Kn + (64 + srow) * 72 + sch * 8) = kr1;
                *(LAS u32x4*)(Vn + srow * 72 + sch * 8) = vr0; *(LAS u32x4*)(Vn + (64 + srow) * 72 + sch * 8) = vr1; }
            __syncthreads();
        }
        {
            float lt; { const auto rr_ = __builtin_amdgcn_permlane32_swap(__float_as_uint(lrun), __float_as_uint(lrun), false, false); lt = __uint_as_float(rr_[0]) + __uint_as_float(rr_[1]); }
            if (hi == 0) wsf[r32] = fast_rcp(lt);
            asm volatile("s_waitcnt lgkmcnt(0)" ::: "memory");
            bf16_t* Ob = (bf16_t*)(ws + WS_O) + (orow0 + qw) * 1024 + colbase + r32;
#pragma unroll
            for (int r = 0; r < 16; ++r) { const int rr = crow(r, hi); const float f = wsf[rr];
                Ob[(size_t)rr * 1024] = (bf16_t)(cvt_pk_bf16(o0[r] * f, 0.f) & 0xffffu); Ob[(size_t)rr * 1024 + 32] = (bf16_t)(cvt_pk_bf16(o1[r] * f, 0.f) & 0xffffu); }
        }
    }
}

constexpr int A2_KV = 0, A2_TAB = 73728, A2_WSF = 76032;
__device__ __forceinline__ void attn_unit_A2(const Args& a, LAS unsigned char* lds, int u, int wave) {
    const int lane = lane_id_fresh(), tid = wave * 64 + lane;
    unsigned char* ws = a.ws;
    const int part = u & 1, bhp = u >> 1, b = bhp >> 2, g = wave >> 2, h = 2 * (bhp & 3) + g, wg = wave & 3, r32 = lane & 31, hi = lane >> 5;
    const size_t hb = (size_t)(b * 8 + h) * 2048 * 64; const bf16_t* base = (const bf16_t*)(ws + WS_QKVP);
    const bf16_t* Q = base + hb; const bf16_t* K = base + PSTRIDE + hb; const bf16_t* V = base + 2 * PSTRIDE + hb;
    const size_t orow0 = (size_t)b * 2048; const int colbase = h * 64;
    LAS bf16_t* Kg = (LAS bf16_t*)(lds + A2_KV + g * 36864); LAS bf16_t* Vg = Kg + 2 * 4608;
    LAS float* tab = (LAS float*)(lds + A2_TAB) + g * 288; LAS float* wsf = (LAS float*)(lds + A2_WSF) + wave * 64;
    __syncthreads();
    {
        const int gt = tid & 255;
        const float off = qk_bound(ws, false, lane) + *(volatile const float*)((const float*)(ws + WS_GAINS) + 264 + h) * LOG2E;
        tab[gt] = a.in[16][h * 257 + gt] * LOG2E - off; if (gt == 0) tab[256] = a.in[16][h * 257 + 256] * LOG2E - off;
    }
    __syncthreads();
    const int gt = tid & 255, srow = gt >> 2, sc = (gt & 3) * 16;
    for (int qb = part; qb < 16; qb += 2) {
        const int q0 = qb * 128, qw = q0 + 32 * wg, c = qw >> 6;
        const int tlo = c > 8 ? c - 8 : 0, thi = c, blo = 2 * qb > 8 ? 2 * qb - 8 : 0, bhi = 2 * qb + 1;
        bf16x8 qr[4];
#pragma unroll
        for (int d0 = 0; d0 < 4; ++d0) qr[d0] = *(const bf16x8*)(Q + (size_t)(qw + r32) * 64 + d0 * 16 + hi * 8);
        float mrun = 0.f, lrun = 0.f; f32x16 o0 = {}, o1 = {};
        u32x4 kr0, kr1, vr0, vr1;
        { const size_t ro = (size_t)(64 * blo + srow) * 64 + sc;
          kr0 = *(const u32x4*)(K + ro); kr1 = *(const u32x4*)(K + ro + 8); vr0 = *(const u32x4*)(V + ro); vr1 = *(const u32x4*)(V + ro + 8); }
        *(LAS u32x4*)(Kg + srow * 72 + sc) = kr0; *(LAS u32x4*)(Kg + srow * 72 + sc + 8) = kr1;
        *(LAS u32x4*)(Vg + srow * 72 + sc) = vr0; *(LAS u32x4*)(Vg + srow * 72 + sc + 8) = vr1;
        __syncthreads();
        for (int t = blo; t <= bhi; ++t) {
            const int cur = (t - blo) & 1;
            if (t < bhi) { const size_t ro = (size_t)(64 * (t + 1) + srow) * 64 + sc;
                kr0 = *(const u32x4*)(K + ro); kr1 = *(const u32x4*)(K + ro + 8); vr0 = *(const u32x4*)(V + ro); vr1 = *(const u32x4*)(V + ro + 8); }
            if (t >= tlo && t <= thi) attn_tile(Kg + cur * 4608, Vg + cur * 4608, qr, tab, wsf, false, 64 * t, qw, lane, o0, o1, mrun, lrun);
            if (t < bhi) { LAS bf16_t* Kn = Kg + (cur ^ 1) * 4608; LAS bf16_t* Vn = Vg + (cur ^ 1) * 4608;
                *(LAS u32x4*)(Kn + srow * 72 + sc) = kr0; *(LAS u32x4*)(Kn + srow * 72 + sc + 8) = kr1;
                *(LAS u32x4*)(Vn + srow * 72 + sc) = vr0; *(LAS u32x4*)(Vn + srow * 72 + sc + 8) = vr1; }
            __syncthreads();
        }
        {
            float lt; { const auto rr_ = __builtin_amdgcn_permlane32_swap(__float_as_uint(lrun), __float_as_uint(lrun), false, false); lt = __uint_as_float(rr_[0]) + __uint_as_float(rr_[1]); }
            if (hi == 0) wsf[r32] = fast_rcp(lt);
            asm volatile("s_waitcnt lgkmcnt(0)" ::: "memory");
            bf16_t* Ob = (bf16_t*)(ws + WS_O) + (orow0 + qw) * 1024 + colbase + r32;
#pragma unroll
            for (int r = 0; r < 16; ++r) { const int rr = crow(r, hi); const float f = wsf[rr];
                Ob[(size_t)rr * 1024] = (bf16_t)(cvt_pk_bf16(o0[r] * f, 0.f) & 0xffffu); Ob[(size_t)rr * 1024 + 32] = (bf16_t)(cvt_pk_bf16(o1[r] * f, 0.f) & 0xffffu); }
        }
    }
}

constexpr int S_KV = 0, S_TAB = 73728, S_WSF = 90368, S_SCAN = 92416;
__device__ __forceinline__ void samp_tile(const LAS bf16_t* Kw, const bf16x8 (&qr)[4], const LAS bf16_t* Vw, const LAS float* tab, LAS float* wsf, const bool modeB, const bool isnew, const int t0,
                                          const int lane, f32x16& o0, f32x16& o1, float& mrun, float& lrun) {
    const int r32 = lane & 31, hi = lane >> 5;
    f32x16 p = {};
#pragma unroll
    for (int d0 = 0; d0 < 4; ++d0) { const bf16x8 kf = *(const LAS bf16x8*)(Kw + r32 * 72 + d0 * 16 + hi * 8); p = __builtin_amdgcn_mfma_f32_32x32x16_bf16(kf, qr[d0], p, 0, 0, 0); }
    if (modeB) {
#pragma unroll
        for (int rg = 0; rg < 4; ++rg) { const f32x4 c0 = *(const LAS f32x4*)(tab + t0 + 8 * rg + 4 * hi);
#pragma unroll
            for (int i = 0; i < 4; ++i) p[4 * rg + i] += c0[i]; }
        if (isnew) {
#pragma unroll
            for (int r = 0; r < 16; ++r) if (crow(r, hi) > r32) p[r] = NEGB; }
    } else {
        if (512 - (t0 + 31) >= 128) { const float c = tab[256];
#pragma unroll
            for (int r = 0; r < 16; ++r) p[r] += c; }
        else {
#pragma unroll
            for (int r = 0; r < 16; ++r) { const int rel = 512 + r32 - (t0 + crow(r, hi)); int i0 = rel < -128 ? -128 : rel; i0 = i0 > 128 ? 128 : i0; p[r] += tab[i0 + 128]; } }
    }
    float sum = 0.f;
#pragma unroll
    for (int r = 0; r < 16; ++r) { p[r] = fast_exp2(p[r] - mrun); sum += p[r]; }
    lrun += sum;
    bf16x8 pa[2];
    pa[0] = pack8(p[0], p[1], p[2], p[3], p[4], p[5], p[6], p[7]); pa[1] = pack8(p[8], p[9], p[10], p[11], p[12], p[13], p[14], p[15]);
    const LAS bf16_t* vb = Vw + (4 * hi + ((lane & 15) >> 2)) * 72 + 16 * ((lane >> 4) & 1) + 4 * (lane & 3);
#pragma unroll
    for (int g = 0; g < 2; ++g) {
#pragma unroll
        for (int d0 = 0; d0 < 2; ++d0) {
            const v4i16_t lo = __builtin_amdgcn_ds_read_tr16_b64_v4i16((LAS v4i16_t*)(vb + (16 * g) * 72 + 32 * d0));
            const v4i16_t up = __builtin_amdgcn_ds_read_tr16_b64_v4i16((LAS v4i16_t*)(vb + (16 * g + 8) * 72 + 32 * d0));
            const bf16x8 vf = (bf16x8){lo[0], lo[1], lo[2], lo[3], up[0], up[1], up[2], up[3]};
            if (d0 == 0) o0 = __builtin_amdgcn_mfma_f32_32x32x16_bf16(pa[g], vf, o0, 0, 0, 0);
            else         o1 = __builtin_amdgcn_mfma_f32_32x32x16_bf16(pa[g], vf, o1, 0, 0, 0);
        }
    }
}
__device__ __forceinline__ void samp_unit(const Args& a, LAS unsigned char* lds, const bool modeB, int bh, int wave) {
    const int lane = lane_id_fresh(), tid = wave * 64 + lane;
    unsigned char* ws = a.ws;
    const int b = bh >> 3, h = bh & 7, r32 = lane & 31, hi = lane >> 5;
    const int P = modeB ? 4096 : 512, ttot = P + 32;
    const float* Kc = a.in[modeB ? 4 : 2] + (size_t)b * P * 512 + h * 64;
    const float* Vc = a.in[modeB ? 5 : 3] + (size_t)b * P * 512 + h * 64;
    const bf16_t* Qn = (const bf16_t*)(ws + (modeB ? WS_QBS : WS_QAS)) + (size_t)(b * 8 + h) * 2048;
    const bf16_t* Kn = (const bf16_t*)(ws + (modeB ? WS_KBN : WS_KAN)) + (size_t)(b * 8 + h) * 2048;
    const bf16_t* Vn = (const bf16_t*)(ws + (modeB ? WS_VBN : WS_VAN)) + (size_t)(b * 8 + h) * 2048;
    LAS bf16_t* Kw = (LAS bf16_t*)(lds + S_KV) + wave * 4608; LAS bf16_t* Vw = Kw + 2304;
    LAS float* tab = (LAS float*)(lds + S_TAB); LAS float* wsf = (LAS float*)(lds + S_WSF) + wave * 64; LAS float* scanw = (LAS float*)(lds + S_SCAN);
    __syncthreads();
    if (modeB) {
        const int per = (ttot + 511) >> 9, k0 = tid * per;
        const float* lf0 = a.in[6] + (size_t)b * 4096 * 8 + h; const float* lf1 = a.out + O_LF_S + (size_t)b * 32 * 8 + h;
        float loc = 0.f;
        for (int i = 0; i < per; ++i) { const int k = k0 + i; if (k < ttot) loc += (k < P) ? lf0[(size_t)k * 8] : lf1[(size_t)(k - P) * 8]; }
        float inc = loc;
#pragma unroll
        for (int o = 1; o < 64; o <<= 1) { const float y = __int_as_float(__builtin_amdgcn_ds_bpermute(((lane - o) & 63) << 2, __float_as_int(inc))); if (lane >= o) inc += y; }
        if (lane == 63) scanw[wave] = inc;
        __syncthreads();
        float run = inc - loc;
        for (int w = 0; w < wave; ++w) run += scanw[w];
        for (int i = 0; i < per; ++i) { const int k = k0 + i; if (k < ttot) { run += (k < P) ? lf0[(size_t)k * 8] : lf1[(size_t)(k - P) * 8]; tab[k] = -run * LOG2E; } }
    } else {
        const float off = qk_bound(ws, false, lane) + *(volatile const float*)((const float*)(ws + WS_GAINS) + 264 + h) * LOG2E;
        for (int i = tid; i < 257; i += 512) tab[i] = a.in[16][h * 257 + i] * LOG2E - off;
    }
    __syncthreads();
    bf16x8 qr[4];
#pragma unroll
    for (int d0 = 0; d0 < 4; ++d0) qr[d0] = *(const bf16x8*)(Qn + r32 * 64 + d0 * 16 + hi * 8);
    float mrun = modeB ? tab[P + r32] + qk_bound(ws, true, lane) : 0.f, lrun = 0.f; f32x16 o0 = {}, o1 = {};
    const int ntile = P >> 5;
    f32x4 rk[8], rv[8];
    const size_t lo_off = (size_t)(lane >> 4) * 512 + 4 * (lane & 15);
    const int lw = (lane >> 4) * 72 + 4 * (lane & 15);
    int t = wave;
    {
#pragma unroll
        for (int j = 0; j < 8; ++j) { rk[j] = __builtin_nontemporal_load((const f32x4*)(Kc + (size_t)t * 16384 + lo_off + (size_t)j * 2048)); rv[j] = __builtin_nontemporal_load((const f32x4*)(Vc + (size_t)t * 16384 + lo_off + (size_t)j * 2048)); }
    }
    for (; t < ntile; t += 8) {
#pragma unroll
        for (int j = 0; j < 8; ++j) { u32x2 wk, wv; wk.x = cvt_pk_bf16(rk[j][0], rk[j][1]); wk.y = cvt_pk_bf16(rk[j][2], rk[j][3]); wv.x = cvt_pk_bf16(rv[j][0], rv[j][1]); wv.y = cvt_pk_bf16(rv[j][2], rv[j][3]);
            *(LAS u32x2*)(Kw + lw + j * 288) = wk; *(LAS u32x2*)(Vw + lw + j * 288) = wv; }
        if (t + 8 < ntile) {
#pragma unroll
            for (int j = 0; j < 8; ++j) { rk[j] = __builtin_nontemporal_load((const f32x4*)(Kc + (size_t)(t + 8) * 16384 + lo_off + (size_t)j * 2048)); rv[j] = __builtin_nontemporal_load((const f32x4*)(Vc + (size_t)(t + 8) * 16384 + lo_off + (size_t)j * 2048)); }
        }
        samp_tile(Kw, qr, Vw, tab, wsf, modeB, false, 32 * t, lane, o0, o1, mrun, lrun);
    }
    if (wave == 0) {
#pragma unroll
        for (int j = 0; j < 4; ++j) { const int row = (lane >> 3) + 8 * j, col = 8 * (lane & 7);
            *(LAS bf16x8*)(Kw + row * 72 + col) = *(const bf16x8*)(Kn + row * 64 + col); *(LAS bf16x8*)(Vw + row * 72 + col) = *(const bf16x8*)(Vn + row * 64 + col); }
        samp_tile(Kw, qr, Vw, tab, wsf, modeB, true, P, lane, o0, o1, mrun, lrun);
    }
    {
        float lt; { const auto rr_ = __builtin_amdgcn_permlane32_swap(__float_as_uint(lrun), __float_as_uint(lrun), false, false); lt = __uint_as_float(rr_[0]) + __uint_as_float(rr_[1]); }
        LAS float* oc = (LAS float*)(lds + S_KV + wave * 9216); LAS float* ml = oc + 2048;
#pragma unroll
        for (int r = 0; r < 16; ++r) { oc[crow(r, hi) * 64 + r32] = o0[r]; oc[crow(r, hi) * 64 + 32 + r32] = o1[r]; }
        if (hi == 0) { ml[2 * r32] = mrun; ml[2 * r32 + 1] = lt; }
    }
    __syncthreads();
    {
        const int q = tid >> 4, d4 = (tid & 15) * 4;
        const LAS float* mlb = (const LAS float*)(lds + S_KV) + 2048 + 2 * q; const LAS float* ocb = (const LAS float*)(lds + S_KV) + q * 64 + d4;
        float M = mlb[0];
#pragma unroll
        for (int w = 1; w < 8; ++w) M = fmaxf(M, mlb[w * 2304]);
        f32x4 num = {0.f, 0.f, 0.f, 0.f}; float den = 0.f;
#pragma unroll
        for (int w = 0; w < 8; ++w) { const float f = fast_exp2(mlb[w * 2304] - M); den += f * mlb[w * 2304 + 1]; num += *(const LAS f32x4*)(ocb + w * 2304) * f; }
        const float inv = 1.0f / den;
        u32x2 w2; w2.x = cvt_pk_bf16(num[0] * inv, num[1] * inv); w2.y = cvt_pk_bf16(num[2] * inv, num[3] * inv);
        *(u32x2*)((bf16_t*)(ws + WS_O) + ((size_t)MP + b * 32 + q) * 1024 + (modeB ? 512 : 0) + h * 64 + d4) = w2;
    }
}

#define XB_TMO      128
#define XB_XCNT(j)  (256  + 64 * (j))
#define XB_XSUB(j)  (1280 + 64 * (j))
#define XB_XGEN(j)  (2304 + 64 * (j))
#define XB_TOP      3328
#define XB_TOPGEN   3392
#define XB_SPIN_CAP (1u << 20)
__device__ __forceinline__ unsigned xb_ld(unsigned* p)              { return __hip_atomic_load(p, __ATOMIC_RELAXED, __HIP_MEMORY_SCOPE_AGENT); }
__device__ __forceinline__ unsigned xb_add(unsigned* p, unsigned v) { return __hip_atomic_fetch_add(p, v, __ATOMIC_RELAXED, __HIP_MEMORY_SCOPE_AGENT); }
__device__ __forceinline__ unsigned xb_xcc_id() { return (unsigned)__builtin_amdgcn_s_getreg((3 << 11) | 20) & 0xFu; }
#define XB_SPIN(cond, bar) do { unsigned _sp = 0; while (cond) { __builtin_amdgcn_s_sleep(1); \
    if ((++_sp & 255u) == 0u) { if (xb_ld(&(bar)[XB_TMO])) break; if (_sp > XB_SPIN_CAP) { atomicAdd(&(bar)[XB_TMO], 1u); break; } } } } while (0)
__device__ __forceinline__ void xcd_barrier_complete(unsigned* bar, unsigned x, unsigned G, unsigned& nloc, unsigned& nx) {
    unsigned sum, cnt, mine, sp = 0u;
    for (;;) {
        sum = 0u; cnt = 0u; mine = 0u;
#pragma unroll
        for (unsigned j = 0; j < 16; ++j) { const unsigned c = xb_ld(&bar[XB_XCNT(j)]); sum += c; cnt += (c > 0u) ? 1u : 0u; mine = (j == x) ? c : mine; }
        if (sum == G) break;
        __builtin_amdgcn_s_sleep(1);
        if ((++sp & 255u) == 0u) { if (xb_ld(&bar[XB_TMO])) break; if (sp > XB_SPIN_CAP) { atomicAdd(&bar[XB_TMO], 1u); break; } }
    }
    nloc = mine > 0u ? mine : 1u; nx = cnt > 0u ? cnt : 1u;
}
__device__ __forceinline__ void grid_bar(unsigned* bar, volatile LAS unsigned* st, unsigned x, unsigned G, int wave) {
    asm volatile("s_waitcnt vmcnt(0)" ::: "memory");
    __syncthreads();
    if (wave == 0 && lane_id_fresh() == 0) {
        __builtin_amdgcn_s_waitcnt(0);
        unsigned nloc = st[0], nx = st[1];
        if (nloc == 0u) { xcd_barrier_complete(bar, x, G, nloc, nx); st[0] = nloc; st[1] = nx; }
        const unsigned old = xb_add(&bar[XB_XSUB(x)], 1u);
        const unsigned gen = old / nloc;
        if (old + 1u == (gen + 1u) * nloc) {
            __builtin_amdgcn_fence(__ATOMIC_RELEASE, "agent");
            asm volatile("s_waitcnt vmcnt(0)" ::: "memory");
            const unsigned og = xb_add(&bar[XB_TOP], 1u);
            const unsigned tg = og / nx;
            if (og + 1u == (tg + 1u) * nx) xb_add(&bar[XB_TOPGEN], 1u);
            else XB_SPIN(xb_ld(&bar[XB_TOPGEN]) == tg, bar);
            __builtin_amdgcn_fence(__ATOMIC_ACQUIRE, "agent");
            xb_add(&bar[XB_XGEN(x)], 1u);
            asm volatile("s_waitcnt vmcnt(0)" ::: "memory");
        } else {
            XB_SPIN(xb_ld(&bar[XB_XGEN(x)]) == gen, bar);
            __builtin_amdgcn_fence(__ATOMIC_ACQUIRE, "agent");
            asm volatile("s_waitcnt vmcnt(0)" ::: "memory");
        }
    }
    __syncthreads();
}

__global__ void __launch_bounds__(512, 2) mk_fwd(Args a) {
    extern __shared__ __attribute__((aligned(16))) unsigned char lds_raw[];
    LAS unsigned char* lds = (LAS unsigned char*)lds_raw;
    const int wave = __builtin_amdgcn_readfirstlane((int)threadIdx.x >> 6);
    unsigned char* ws = a.ws;
    const int lo = a.ph_lo, hi = a.ph_hi, G = gridDim.x, c = blockIdx.x;
#if MK_N_LAUNCHES == 1
    if (lo < 0) cg::this_grid().sync();
    volatile LAS unsigned* xb_st = (volatile LAS unsigned*)(lds + (LDS_BYTES - 16));
    const unsigned xb_x = xb_xcc_id();
    if (wave == 0 && lane_id_fresh() == 0) { xb_st[0] = 0u; xb_st[1] = 0u; (void)xb_add(&((unsigned*)ws)[XB_XCNT(xb_x)], 1u); }
    __syncthreads();
#define SEAM(k) do { if (lo <= (k) && (k) + 1 < hi) grid_bar((unsigned*)ws, xb_st, xb_x, (unsigned)G, wave); } while (0)
#else
#define SEAM(k) do { } while (0)
#endif
#define IN(k) (lo <= (k) && (k) < hi)
    if (IN(0)) { phase0(a, lds, wave); SEAM(0); }
    if (IN(1)) {
        pg8::Gemm g{(const bf16_t*)(ws + WS_XB), (const bf16_t*)(ws + WS_WQKV), MT, NQKV, 1024}; pg8::StaticOrder S; S.init(MT, NQKV, G, c);
        EpiQKV E{(const float*)(ws + WS_RSTD0), (const float*)(ws + WS_GAINS), ws, a.out};
        pg8::gemm_phase<EpiQKV, pg8::StaticOrder, true, true>(lds, g, S, E, wave);
        { int rk_, cn_; shadow_share((MT / 256) * (NQKV / 256), G, c, rk_, cn_); if (cn_ > 0) tr_set(a, lds, wave, lane_id_fresh(), 1, rk_ * 8 + wave, cn_ * 8); }
        SEAM(1);
    }
    if (IN(2)) {
        for (int i = 0; i < 4; ++i) { const int ty = (c & 1) ? ((i + 2) & 3) : i;
            for (int bh0 = c; bh0 < 256; bh0 += G) { int bh = bh0; asm volatile("" : "+s"(bh));
                if (ty == 0) { int one = 1; asm volatile("" : "+s"(one)); attn_unit(a, lds, one != 0, bh, wave); } else if (ty == 1) attn_unit_A2(a, lds, bh, wave); else samp_unit(a, lds, ty == 2, bh, wave); } }
        SEAM(2);
    }
    if (IN(3)) {
        { pg8::Gemm g{(const bf16_t*)(ws + WS_O), (const bf16_t*)(ws + WS_WO), MT, 1024, 1024}; pg8::StaticOrder S; S.init(MT, 1024, G, c);
          EpiRes<false> E{nullptr, nullptr, (bf16_t*)(ws + WS_XB), (float*)(ws + WS_SSQ1)};
          pg8::gemm_phase<EpiRes<false>, pg8::StaticOrder, true, true>(lds, g, S, E, wave); }
        { int rk_, cn_; shadow_share((MT / 256) * 4, G, c, rk_, cn_); if (cn_ > 0) p_convert(a, (size_t)rk_ * 512 + wave * 64 + lane_id_fresh(), (size_t)cn_ * 512); }
        SEAM(3);
    }
    if (IN(4)) {
        pg8::Gemm g{(const bf16_t*)(ws + WS_XB), (const bf16_t*)(ws + WS_WGU), MT, 2 * DFF, 1024}; pg8::StaticOrder S; S.init(MT, 2 * DFF, G, c);
        EpiSwiGLU E{(const float*)(ws + WS_SSQ1), (bf16_t*)(ws + WS_H)};
        pg8::gemm_phase<EpiSwiGLU, pg8::StaticOrder, true, true>(lds, g, S, E, wave);
        { int rk_, cn_; shadow_share((MT / 256) * (2 * DFF / 256), G, c, rk_, cn_); if (cn_ > 0) tr_set(a, lds, wave, lane_id_fresh(), 2, rk_ * 8 + wave, cn_ * 8); }
        SEAM(4);
    }
    if (IN(5)) {
        pg8::Gemm g{(const bf16_t*)(ws + WS_H), (const bf16_t*)(ws + WS_WD), MT, 1024, DFF}; pg8::StaticOrder S; S.init(MT, 1024, G, c);
        EpiRes<false> E{nullptr, nullptr, (bf16_t*)(ws + WS_XB), (float*)(ws + WS_SSQ2)};
        pg8::gemm_phase<EpiRes<false>, pg8::StaticOrder, true, true>(lds, g, S, E, wave);
        {
            const int nu = (MT / 256) * 4, tailc = nu - (nu / G) * G;
            const bool split = tailc > 0 && tailc * 2 < G;
            if (!split || c >= tailc) {
                pg8::Gemm g2{(const bf16_t*)(ws + WS_PB), (const bf16_t*)(ws + WS_WPP), MT, 1024, PLE}; pg8::StaticOrder S2; S2.init(MT, 1024, split ? G - tailc : G, split ? c - tailc : c);
                EpiStore E2{(bf16_t*)(ws + WS_PP), 1024};
                pg8::gemm_phase<EpiStore, pg8::StaticOrder, true, true>(lds, g2, S2, E2, wave);
            }
        }
        SEAM(5);
    }
    if (IN(6)) {
        pg8::Gemm g{(const bf16_t*)(ws + WS_XB), (const bf16_t*)(ws + WS_WPG), MT, 1024, 1024}; pg8::StaticOrder S; S.init(MT, 1024, G, c);
        EpiPle E{(const float*)(ws + WS_SSQ2), (const bf16_t*)(ws + WS_PP), (const bf16_t*)(ws + WS_XB), a.out + O_Y};
        pg8::gemm_phase<EpiPle, pg8::StaticOrder, true, true>(lds, g, S, E, wave);
    }
#undef IN
#undef SEAM
}

extern "C" void kernel_launch(void* const* d_in, const int* in_sizes, int n_in, void* d_out, int out_size, void* d_ws, size_t ws_size, hipStream_t stream) {
    static int grid = 0;
    if (grid == 0) {
        if (n_in != 25 || (size_t)out_size != O_END || ws_size < WS_END) { fprintf(stderr, "kernel_launch: unexpected shapes: n_in %d out %d (want %zu) ws %zu (want >= %zu)\n", n_in, out_size, (size_t)O_END, ws_size, (size_t)WS_END); if (n_in != 25 || ws_size < WS_END) { grid = -1; return; } }
        int dev = 0, cus = 0, per_cu = 0;
        if (hipGetDevice(&dev) != hipSuccess || hipDeviceGetAttribute(&cus, hipDeviceAttributeMultiprocessorCount, dev) != hipSuccess) { grid = -1; return; }
        if (hipFuncSetAttribute((const void*)mk_fwd, hipFuncAttributeMaxDynamicSharedMemorySize, LDS_BYTES) != hipSuccess) { fprintf(stderr, "kernel_launch: hipFuncSetAttribute failed\n"); grid = -1; return; }
        if (hipOccupancyMaxActiveBlocksPerMultiprocessor(&per_cu, (const void*)mk_fwd, 512, LDS_BYTES) != hipSuccess || per_cu < 1) { fprintf(stderr, "kernel_launch: occupancy query says %d\n", per_cu); per_cu = 1; }
        (void)hipGetLastError();
        grid = cus * per_cu;
    }
    if (grid < 0) return;
    Args a{};
    for (int i = 0; i < 25; ++i) a.in[i] = (const float*)d_in[i];
    a.out = (float*)d_out; a.ws = (unsigned char*)d_ws;
#if MK_N_LAUNCHES == 1
    a.ph_lo = 0; a.ph_hi = 7;
    if (hipMemsetAsync(d_ws, 0, 16384, stream) != hipSuccess) { fprintf(stderr, "kernel_launch: memset failed\n"); return; }
    void* args[] = {&a};
    hipError_t e = hipLaunchCooperativeKernel((const void*)mk_fwd, dim3(grid), dim3(512), args, LDS_BYTES, stream);
    if (e != hipSuccess) fprintf(stderr, "kernel_launch: cooperative launch failed: %s (grid %d)\n", hipGetErrorString(e), grid);
#else
    for (int ph = 0; ph < 7; ++ph) { a.ph_lo = ph; a.ph_hi = ph + 1; hipLaunchKernelGGL(mk_fwd, dim3(grid), dim3(512), LDS_BYTES, stream, a); }
#endif
}
```
